# Optimizing an MI355X kernel written in HIP

```python
import jax, jax.numpy as jnp
from jax import lax
import numpy as np

D_MODEL = 1024
BATCH = 2
SEQ = 16384
DEPTH = 2

GRID_W = 64
CTX_LEN = 256
N_EVEN = (DEPTH + 1) // 2
N_ODD = DEPTH // 2
HEAD_DIM = 64
ATTN_HEADS = 8
KV_HEADS = 2
GQA_GROUP = ATTN_HEADS // KV_HEADS
WINDOW = 128
ATTN_BLOCK = 128
ROPE_BASE = 10000.0
GMLP_GROUPS = 8
GMLP_DIM = 64
CHUNK = 128
Q_W = ATTN_HEADS * HEAD_DIM
KV_W = KV_HEADS * HEAD_DIM
A_W = GMLP_GROUPS * GMLP_DIM
IN_W = Q_W + 2 * KV_W + 2 * A_W
MIX_W = Q_W + A_W
POOL_WINDOWS = (2, 4, 8, 16)
POOL_GROUPS = 4
POOL_DIM = D_MODEL // POOL_GROUPS
PEER_HEADS = 8
PEER_NKEYS = 128
PEER_EXPERTS = PEER_NKEYS * PEER_NKEYS
PEER_TOPK = 16
PEER_DKEY = 256
PEER_DHALF = PEER_DKEY // 2
PEER_BLOCK = 128
N_MOD = 6
EPS = 1e-6

kernel_name = 'hybrid_swa_gmlp_pool_peer_dit'


def rms_norm(x, g):
    xf = x.astype(jnp.float32)
    y = xf * lax.rsqrt(jnp.mean(jnp.square(xf), axis=-1, keepdims=True) + EPS)
    return (y * g).astype(x.dtype)


def axial_rope(t, row, col):
    half = HEAD_DIM // 2
    quarter = half // 2
    inv = jnp.power(ROPE_BASE, -jnp.arange(quarter, dtype=jnp.float32) / quarter)

    def rot(xa, pos):
        ang = pos[:, None] * inv[None, :]
        cos = jnp.cos(ang)[None, :, None, :]
        sin = jnp.sin(ang)[None, :, None, :]
        x1, x2 = xa[..., :quarter], xa[..., quarter:]
        return jnp.concatenate([x1 * cos - x2 * sin, x1 * sin + x2 * cos], axis=-1)

    tf = t.astype(jnp.float32)
    return jnp.concatenate([rot(tf[..., :half], row), rot(tf[..., half:], col)], axis=-1).astype(t.dtype)


def sink_softmax(logits, sink):
    sk = jnp.broadcast_to(sink.astype(jnp.float32).reshape(1, KV_HEADS, GQA_GROUP, 1, 1), logits.shape[:-1] + (1,))
    return jax.nn.softmax(jnp.concatenate([logits, sk], axis=-1), axis=-1)[..., :-1]


def window_attention(q, k, v, k_ctx, v_ctx, sink):
    B_, L_ = q.shape[0], q.shape[1]
    nb = L_ // ATTN_BLOCK
    span = ATTN_BLOCK + 2 * WINDOW
    scale = HEAD_DIM ** -0.5
    pad = ((0, 0), (WINDOW, WINDOW), (0, 0), (0, 0))
    kp = jnp.pad(k, pad)
    vp = jnp.pad(v, pad)
    qb = q.reshape(B_, nb, ATTN_BLOCK, KV_HEADS, GQA_GROUP, HEAD_DIM).swapaxes(0, 1)

    def one_block(args):
        n, qn = args
        start = n * ATTN_BLOCK
        kn = lax.dynamic_slice_in_dim(kp, start, span, axis=1)
        vn = lax.dynamic_slice_in_dim(vp, start, span, axis=1)
        qpos = start + jnp.arange(ATTN_BLOCK)
        kpos = start - WINDOW + jnp.arange(span)
        valid = (jnp.abs(qpos[:, None] - kpos[None, :]) <= WINDOW) & (kpos >= 0)[None, :] & (kpos < L_)[None, :]
        s_loc = jnp.einsum('bqhgd,bkhd->bhgqk', qn, kn).astype(jnp.float32) * scale
        s_loc = jnp.where(valid, s_loc, -jnp.inf)
        s_ctx = jnp.einsum('bqhgd,bkhd->bhgqk', qn, k_ctx).astype(jnp.float32) * scale
        p = sink_softmax(jnp.concatenate([s_loc, s_ctx], axis=-1), sink)
        o = (jnp.einsum('bhgqk,bkhd->bqhgd', p[..., :span], vn.astype(jnp.float32))
             + jnp.einsum('bhgqk,bkhd->bqhgd', p[..., span:], v_ctx.astype(jnp.float32)))
        return o.astype(q.dtype)

    out = lax.map(one_block, (jnp.arange(nb), qb))
    return out.swapaxes(0, 1).reshape(B_, L_, Q_W)


def context_attention(qc, kc, vc, sink):
    B_, C_ = qc.shape[0], qc.shape[1]
    qg = qc.reshape(B_, C_, KV_HEADS, GQA_GROUP, HEAD_DIM)
    s = jnp.einsum('bqhgd,bkhd->bhgqk', qg, kc).astype(jnp.float32) * (HEAD_DIM ** -0.5)
    p = sink_softmax(s, sink)
    o = jnp.einsum('bhgqk,bkhd->bqhgd', p, vc.astype(jnp.float32))
    return o.astype(qc.dtype).reshape(B_, C_, Q_W)


def chunk_gmlp(ua, va, w_s, b_s):
    B_, L_ = ua.shape[0], ua.shape[1]
    u = jax.nn.gelu(ua).reshape(B_, L_, GMLP_GROUPS, GMLP_DIM)
    vf = jax.nn.gelu(va).reshape(B_, L_, GMLP_GROUPS, GMLP_DIM).astype(jnp.float32)
    mu = jnp.mean(vf, axis=-1, keepdims=True)
    var = jnp.mean(jnp.square(vf - mu), axis=-1, keepdims=True)
    v = ((vf - mu) * lax.rsqrt(var + EPS)).astype(ua.dtype)
    vc = v.reshape(B_, L_ // CHUNK, CHUNK, GMLP_GROUPS, GMLP_DIM)
    mixed = jnp.einsum('gpq,bcqgd->bcpgd', w_s, vc) + b_s.T[:, :, None]
    return (u * mixed.reshape(B_, L_, GMLP_GROUPS, GMLP_DIM)).reshape(B_, L_, A_W)


def split_proj(p):
    return jnp.split(p, [Q_W, Q_W + KV_W, Q_W + 2 * KV_W, Q_W + 2 * KV_W + A_W], axis=-1)


def attn_gmlp_mixer(h, hc, w_in, w_out, sink, w_s, b_s, row, col, need_ctx_out):
    B_, L_ = h.shape[0], h.shape[1]
    C_ = hc.shape[1]
    q, k, v, ua, va = split_proj(h @ w_in)
    q = axial_rope(q.reshape(B_, L_, ATTN_HEADS, HEAD_DIM), row, col)
    k = axial_rope(k.reshape(B_, L_, KV_HEADS, HEAD_DIM), row, col)
    v = v.reshape(B_, L_, KV_HEADS, HEAD_DIM)
    if need_ctx_out:
        qc, kc, vc, uac, vac = split_proj(hc @ w_in)
    else:
        kc, vc = jnp.split(hc @ w_in[:, Q_W:Q_W + 2 * KV_W], 2, axis=-1)
    kc = kc.reshape(B_, C_, KV_HEADS, HEAD_DIM)
    vc = vc.reshape(B_, C_, KV_HEADS, HEAD_DIM)
    attn = window_attention(q, k, v, kc, vc, sink)
    mix = chunk_gmlp(ua, va, w_s, b_s)
    y = jnp.concatenate([attn, mix], axis=-1) @ w_out
    yc = None
    if need_ctx_out:
        attn_c = context_attention(qc.reshape(B_, C_, ATTN_HEADS, HEAD_DIM), kc, vc, sink)
        mix_c = chunk_gmlp(uac, vac, w_s, b_s)
        yc = jnp.concatenate([attn_c, mix_c], axis=-1) @ w_out
    return y, yc


def multiscale_pool(h, w_pool, scale):
    B_, L_ = h.shape[0], h.shape[1]
    hf = h.reshape(B_, L_, POOL_GROUPS, POOL_DIM).astype(jnp.float32)
    cs = jnp.pad(lax.cumsum(hf, axis=1), ((0, 0), (1, 0), (0, 0), (0, 0)))
    t = jnp.arange(L_)
    diffs = []
    for g, w in enumerate(POOL_WINDOWS):
        lo = jnp.clip(t - w // 2, 0, L_)
        hi = jnp.clip(t + w // 2, 0, L_)
        mean = (cs[:, hi, g] - cs[:, lo, g]) / (hi - lo).astype(jnp.float32)[None, :, None]
        diffs.append(mean - hf[:, :, g])
    pooled = jnp.stack(diffs, axis=2).astype(h.dtype)
    y = jnp.einsum('blgc,gce->blge', pooled, w_pool).reshape(B_, L_, D_MODEL)
    return y * scale


def peer_ffn(h, w_q, sub_keys, down, up):
    shape = h.shape
    blocks = h.reshape(-1, PEER_BLOCK, D_MODEL)

    def one_block(xb):
        n = xb.shape[0]
        q = (xb @ w_q).reshape(n, PEER_HEADS, 2, PEER_DHALF)
        s = jnp.einsum('thpk,pnk->thpn', q, sub_keys).astype(jnp.float32)
        s_top, i_top = lax.top_k(s, PEER_TOPK)
        cand_s = s_top[:, :, 0, :, None] + s_top[:, :, 1, None, :]
        cand_i = i_top[:, :, 0, :, None] * PEER_NKEYS + i_top[:, :, 1, None, :]
        best_s, best_pos = lax.top_k(cand_s.reshape(n, PEER_HEADS, -1), PEER_TOPK)
        idx = jnp.take_along_axis(cand_i.reshape(n, PEER_HEADS, -1), best_pos, axis=-1)
        gate = jax.nn.softmax(best_s, axis=-1)
        u = jnp.take(down, idx, axis=0)
        act = jax.nn.gelu(jnp.einsum('thkd,td->thk', u, xb))
        v = jnp.take(up, idx, axis=0)
        return jnp.einsum('thk,thkd->td', (gate * act).astype(v.dtype), v)

    return lax.map(one_block, blocks).reshape(shape)


def setup_inputs(seed: int = 0) -> dict:
    key = jax.random.key(seed)
    ks = jax.random.split(key, 20)
    D = D_MODEL

    def nrm(k, shape, s):
        return jax.random.normal(k, shape, jnp.float32) * s

    return {
        'x': nrm(ks[0], (BATCH, SEQ, D), 1.0),
        'c': nrm(ks[1], (BATCH, D), 1.0),
        'ctx': nrm(ks[2], (BATCH, CTX_LEN, D), 1.0),
        'c_ctx': nrm(ks[3], (D,), 1.0),
        'mod_w': nrm(ks[4], (DEPTH, D, N_MOD * D), 0.5 * D ** -0.5),
        'mod_b': nrm(ks[5], (DEPTH, N_MOD * D), 0.02),
        'norm1_g': 1.0 + nrm(ks[6], (DEPTH, D), 0.02),
        'norm2_g': 1.0 + nrm(ks[7], (DEPTH, D), 0.02),
        'attn_in_w': nrm(ks[8], (N_EVEN, D, IN_W), D ** -0.5),
        'attn_out_w': nrm(ks[9], (N_EVEN, MIX_W, D), MIX_W ** -0.5),
        'attn_sink': nrm(ks[10], (N_EVEN, ATTN_HEADS), 0.5),
        'gmlp_w_s': nrm(ks[11], (N_EVEN, GMLP_GROUPS, CHUNK, CHUNK), CHUNK ** -0.5),
        'gmlp_b_s': 1.0 + nrm(ks[12], (N_EVEN, GMLP_GROUPS, CHUNK), 0.02),
        'pool_w': nrm(ks[13], (N_ODD, POOL_GROUPS, POOL_DIM, POOL_DIM), POOL_DIM ** -0.5),
        'pool_scale': 1.0 + nrm(ks[14], (N_ODD, D), 0.02),
        'peer_w_q': nrm(ks[15], (DEPTH, D, PEER_HEADS * PEER_DKEY), D ** -0.5),
        'peer_sub_keys': nrm(ks[16], (DEPTH, 2, PEER_NKEYS, PEER_DHALF), PEER_DHALF ** -0.5),
        'peer_down': nrm(ks[17], (DEPTH, PEER_EXPERTS, D), D ** -0.5),
        'peer_up': nrm(ks[18], (DEPTH, PEER_EXPERTS, D), 0.5),
        'final_g': 1.0 + nrm(ks[19], (D,), 0.02),
    }


def reference(x, c, ctx, c_ctx, mod_w, mod_b, norm1_g, norm2_g, attn_in_w, attn_out_w, attn_sink,
              gmlp_w_s, gmlp_b_s, pool_w, pool_scale, peer_w_q, peer_sub_keys, peer_down, peer_up, final_g):
    L_ = x.shape[1]
    ROWS = L_ // GRID_W
    t = jnp.arange(ROWS * GRID_W)
    row = (t // GRID_W).astype(jnp.float32)
    col = (t % GRID_W).astype(jnp.float32)
    last_reader = ((DEPTH - 1) // 2) * 2
    xc = ctx
    for l in range(DEPTH):
        has_ctx = l <= last_reader
        keep_ctx = l < last_reader
        m = jax.nn.silu(c) @ mod_w[l] + mod_b[l]
        sh1, sc1, g1, sh2, sc2, g2 = jnp.split(m[:, None, :], N_MOD, axis=-1)
        h = rms_norm(x, norm1_g[l]) * (1.0 + sc1) + sh1
        hc = None
        if has_ctx:
            mc = jax.nn.silu(c_ctx) @ mod_w[l] + mod_b[l]
            csh1, csc1, cg1, csh2, csc2, cg2 = jnp.split(mc, N_MOD, axis=-1)
            hc = rms_norm(xc, norm1_g[l]) * (1.0 + csc1) + csh1
        if l % 2 == 0:
            e = l // 2
            y, yc = attn_gmlp_mixer(h, hc, attn_in_w[e], attn_out_w[e], attn_sink[e],
                                    gmlp_w_s[e], gmlp_b_s[e], row, col, keep_ctx)
        else:
            o = l // 2
            y = multiscale_pool(h, pool_w[o], pool_scale[o])
            yc = multiscale_pool(hc, pool_w[o], pool_scale[o]) if keep_ctx else None
        x = x + g1 * y
        h2 = rms_norm(x, norm2_g[l]) * (1.0 + sc2) + sh2
        x = x + g2 * peer_ffn(h2, peer_w_q[l], peer_sub_keys[l], peer_down[l], peer_up[l])
        if keep_ctx:
            xc = xc + cg1 * yc
            hc2 = rms_norm(xc, norm2_g[l]) * (1.0 + csc2) + csh2
            xc = xc + cg2 * peer_ffn(hc2, peer_w_q[l], peer_sub_keys[l], peer_down[l], peer_up[l])
    return rms_norm(x, final_g)
```

```cpp
#include <hip/hip_runtime.h>
#include <hip/hip_cooperative_groups.h>
#include <cstdio>
#include <type_traits>
namespace cg = cooperative_groups;

#define LAS __attribute__((address_space(3)))
typedef unsigned short bf16_t;
typedef short bf16x8 __attribute__((ext_vector_type(8)));
typedef __bf16 bf16v2 __attribute__((ext_vector_type(2)));
typedef float f32x4 __attribute__((ext_vector_type(4)));
typedef float f32x2 __attribute__((ext_vector_type(2)));
typedef unsigned u32x4 __attribute__((ext_vector_type(4)));
typedef unsigned u32x2 __attribute__((ext_vector_type(2)));

constexpr int DM = 1024, NB = 2, SEQL = 16384, NT = NB * SEQL, CTXL = 256, NTC = NB * CTXL, NTALL = NT + NTC;
constexpr int INW = 1792, NEXP = 16384;
constexpr int NTHREADS = 512, NWAVES = 8;
constexpr int LDS_BYTES = 135168;

constexpr size_t WS_BAR   = 0;
constexpr size_t WS_MOD   = 16384;
constexpr size_t WS_ROPE  = WS_MOD + 131072;
constexpr size_t WS_WIN   = WS_ROPE + 32768;
constexpr size_t WS_WOUT  = WS_WIN + (size_t)INW * DM * 2;
constexpr size_t WS_WQ    = WS_WOUT + (size_t)DM * DM * 2;
constexpr size_t WS_WPOOL = WS_WQ + (size_t)2 * 2048 * DM * 2;
constexpr size_t WS_SK    = WS_WPOOL + (size_t)1024 * 256 * 2;
constexpr size_t WS_WS    = WS_SK + (size_t)2 * 2 * 128 * 128 * 2;
constexpr size_t WS_TD8   = WS_WS + (size_t)8 * 128 * 128 * 2;
constexpr size_t WS_TU8   = WS_TD8 + (size_t)2 * NEXP * DM;
constexpr size_t WS_SD    = WS_TU8 + (size_t)2 * NEXP * DM;
constexpr size_t WS_SU    = WS_SD + (size_t)2 * NEXP * 4;
constexpr size_t WS_H     = WS_SU + (size_t)2 * NEXP * 4;
constexpr size_t WS_R1    = WS_H + (size_t)NTALL * DM * 2;
constexpr size_t WS_CAT   = WS_R1;
constexpr size_t WS_QB    = WS_CAT + (size_t)NT * DM * 2;
constexpr size_t WS_KB    = WS_QB + (size_t)NT * 512 * 2;
constexpr size_t WS_VT    = WS_KB + (size_t)NT * 128 * 2;
constexpr size_t WS_KC    = WS_VT + (size_t)NT * 128 * 2;
constexpr size_t WS_VCT   = WS_KC + (size_t)NTC * 128 * 2;
constexpr size_t WS_UB    = WS_VCT + (size_t)NTC * 128 * 2;
constexpr size_t WS_GT    = WS_UB + (size_t)NT * 512 * 2;
constexpr size_t WS_Y     = WS_QB;
constexpr size_t WS_QP    = WS_QB;
constexpr size_t WS_R1END = WS_QP + (size_t)NT * 2048 * 2;
constexpr size_t WS_IDX   = WS_R1END;
constexpr size_t WS_GW    = WS_IDX + (size_t)NT * 128 * 4;
#ifndef UP4_MFMA
#define UP4_MFMA 1
#endif
#ifndef UP4_MASK
#define UP4_MASK 3
#endif
constexpr size_t WS_PART  = WS_QP;
constexpr size_t WS_CF    = WS_GW + (size_t)NT * 128 * 4;
constexpr size_t WS_XR    = WS_CF + (size_t)NT * 128 * 4;
constexpr size_t WS_HQ    = WS_XR + (size_t)NT * DM * 2;
constexpr size_t WS_HS    = WS_HQ + (size_t)NT * 1024;
constexpr size_t WS_END   = WS_HS + (size_t)NT * 32;
static_assert(WS_GT + (size_t)NT * 512 * 2 <= WS_R1END, "layout");
static_assert(NT / 2 == SEQL, "the PEER passes split the tokens in two halves and take one half = one batch");

struct Params {
  const float *x, *c, *ctx, *c_ctx, *mod_w, *mod_b, *norm1_g, *norm2_g, *attn_in_w, *attn_out_w, *attn_sink, *gmlp_w_s, *gmlp_b_s,
      *pool_w, *pool_scale, *peer_w_q, *peer_sub_keys, *peer_down, *peer_up, *final_g;
  float* out; unsigned char* ws;
};

__device__ __forceinline__ unsigned pk2(float lo, float hi) { unsigned r; asm volatile("v_cvt_pk_bf16_f32 %0, %1, %2" : "=v"(r) : "v"(lo), "v"(hi)); return r; }
__device__ __forceinline__ float bf_lo(unsigned w) { return __uint_as_float(w << 16); }
__device__ __forceinline__ float bf_hi(unsigned w) { return __uint_as_float(w & 0xffff0000u); }
template <int CTRL> __device__ __forceinline__ float dppf(float v) { return __builtin_bit_cast(float, __builtin_amdgcn_update_dpp(0, __builtin_bit_cast(int, v), CTRL, 0xf, 0xf, true)); }
constexpr unsigned LDS_WAVETAB = 131072 + 256;
__device__ __forceinline__ int opaque_tid() {
  const unsigned hw = __builtin_amdgcn_s_getreg((5 << 11) | 4);
  const unsigned w = *(volatile LAS unsigned*)(size_t)(LDS_WAVETAB + 4 * hw);
  unsigned z = 0u; asm volatile("" : "+v"(z));
  int t = (int)((w << 6) | __builtin_amdgcn_mbcnt_hi(~0u, __builtin_amdgcn_mbcnt_lo(~0u, z)));
  asm volatile("" : "+v"(t)); return t; }
__device__ __forceinline__ float swap16_sum(float x, float y) {
  const auto s = __builtin_amdgcn_permlane16_swap(__float_as_uint(x), __float_as_uint(y), false, false);
  const unsigned r0 = s[0], r1 = s[1];
  return __uint_as_float(r0) + __uint_as_float(r1);
}
__device__ __forceinline__ float swap32_sum(float x, float y) {
  const auto s = __builtin_amdgcn_permlane32_swap(__float_as_uint(x), __float_as_uint(y), false, false);
  const unsigned r0 = s[0], r1 = s[1];
  return __uint_as_float(r0) + __uint_as_float(r1);
}
__device__ __forceinline__ float wave_sum(float v) {
  v += dppf<0xB1>(v); v += dppf<0x4E>(v); v += dppf<0x141>(v); v += dppf<0x128>(v);
  v = swap16_sum(v, v); return swap32_sum(v, v);
}
__device__ __forceinline__ float xor16_max(float x) { const auto s = __builtin_amdgcn_permlane16_swap(__float_as_uint(x), __float_as_uint(x), false, false); const unsigned r0 = s[0], r1 = s[1]; return fmaxf(__uint_as_float(r0), __uint_as_float(r1)); }
__device__ __forceinline__ float xor32_max(float x) { const auto s = __builtin_amdgcn_permlane32_swap(__float_as_uint(x), __float_as_uint(x), false, false); const unsigned r0 = s[0], r1 = s[1]; return fmaxf(__uint_as_float(r0), __uint_as_float(r1)); }
__device__ __forceinline__ float wave_max(float v) {
  v = fmaxf(v, dppf<0xB1>(v)); v = fmaxf(v, dppf<0x4E>(v)); v = fmaxf(v, dppf<0x141>(v)); v = fmaxf(v, dppf<0x128>(v));
  return xor32_max(xor16_max(v));
}
__device__ __forceinline__ float gelu_tanh(float x) {
  const float u = 1.5957691216057308f * (x + 0.044715f * x * x * x);
  return x * __builtin_amdgcn_rcpf(1.0f + __expf(-u));
}
__device__ __forceinline__ float silu(float x) { return x * __builtin_amdgcn_rcpf(1.0f + __expf(-x)); }


#define XB_TMO      128
#define XB_XCNT(j)  (256  + 64 * (j))
#define XB_XSUB(j)  (1280 + 64 * (j))
#define XB_XGEN(j)  (2304 + 64 * (j))
#define XB_TOP      3328
#define XB_TOPGEN   3392
#define XCD_BAR_WORDS 3456
#define XB_SPIN_CAP (1u << 18)
__device__ __forceinline__ unsigned xb_ld(unsigned* p)              { return __hip_atomic_load(p, __ATOMIC_RELAXED, __HIP_MEMORY_SCOPE_AGENT); }
__device__ __forceinline__ unsigned xb_add(unsigned* p, unsigned v) { return __hip_atomic_fetch_add(p, v, __ATOMIC_RELAXED, __HIP_MEMORY_SCOPE_AGENT); }
__device__ __forceinline__ unsigned xb_xcc_id() { return (unsigned)__builtin_amdgcn_s_getreg((3 << 11) | 20) & 0xFu; }
#define XB_SPIN(cond, bar) do { unsigned _sp = 0; while (cond) { __builtin_amdgcn_s_sleep(1); \
    if ((++_sp & 255u) == 0u) { if (xb_ld(&(bar)[XB_TMO])) break; if (_sp > XB_SPIN_CAP) { atomicAdd(&(bar)[XB_TMO], 1u); break; } } } } while (0)
struct XcdBarrier { unsigned* bar; unsigned x; volatile LAS unsigned* st; };
__device__ __forceinline__ XcdBarrier xcd_barrier_post(unsigned* bar, volatile LAS unsigned* st) {
  XcdBarrier b; b.bar = bar; b.x = xb_xcc_id(); b.st = st;
  if (opaque_tid() == 0) (void)xb_add(&bar[XB_XCNT(b.x)], 1u);
  return b;
}
__device__ __forceinline__ void xcd_barrier_complete(unsigned* bar, unsigned x, unsigned& nloc, unsigned& nx) {
  const unsigned G = gridDim.x * gridDim.y * gridDim.z;
  unsigned sum, cnt, mine, sp = 0u;
  for (;;) {
    sum = 0u; cnt = 0u; mine = 0u;
#pragma unroll
    for (unsigned j = 0; j < 16; ++j) { const unsigned c = xb_ld(&bar[XB_XCNT(j)]); sum += c; cnt += (c > 0u) ? 1u : 0u; mine = (j == x) ? c : mine; }
    if (sum == G) break;
    __builtin_amdgcn_s_sleep(1);
    if ((++sp & 255u) == 0u) { if (xb_ld(&bar[XB_TMO])) break; if (sp > XB_SPIN_CAP) { atomicAdd(&bar[XB_TMO], 1u); break; } }
  }
  nloc = mine > 0u ? mine : 1u; nx = cnt > 0u ? cnt : 1u;
}
__device__ __forceinline__ void xcd_barrier(const XcdBarrier& b) {
  asm volatile("s_waitcnt vmcnt(0)" ::: "memory");
  __syncthreads();
  if (opaque_tid() == 0) {
    unsigned* bar = b.bar;
    __builtin_amdgcn_s_waitcnt(0);
    unsigned nloc = b.st[0], nx = b.st[1];
    if (nloc == 0u) { xcd_barrier_complete(bar, b.x, nloc, nx); b.st[0] = nloc; b.st[1] = nx; }
    const unsigned old = xb_add(&bar[XB_XSUB(b.x)], 1u);
    const unsigned gen = old / nloc;
    if (old + 1u == (gen + 1u) * nloc) {
      __builtin_amdgcn_fence(__ATOMIC_RELEASE, "agent");
      asm volatile("s_waitcnt vmcnt(0)" ::: "memory");
      const unsigned og = xb_add(&bar[XB_TOP], 1u);
      const unsigned tg = og / nx;
      if (og + 1u == (tg + 1u) * nx) xb_add(&bar[XB_TOPGEN], 1u);
      else XB_SPIN(xb_ld(&bar[XB_TOPGEN]) == tg, bar);
      __builtin_amdgcn_fence(__ATOMIC_ACQUIRE, "agent");
      xb_add(&bar[XB_XGEN(b.x)], 1u);
      asm volatile("s_waitcnt vmcnt(0)" ::: "memory");
    } else {
      XB_SPIN(xb_ld(&bar[XB_XGEN(b.x)]) == gen, bar);
      __builtin_amdgcn_fence(__ATOMIC_ACQUIRE, "agent");
      asm volatile("s_waitcnt vmcnt(0)" ::: "memory");
    }
  }
  __syncthreads();
}

namespace pg8 {
constexpr int BM = 256, BK = 64, HALF = 128, HTB = HALF * BK * 2, STAGE_BYTES = 8 * HTB, NXCD = 8, WGM = 8;
__device__ __forceinline__ int lds_byte(int r, int c) { const int st = (r >> 4) * 2 + (c >> 5), rr = r & 15, cc = c & 31, ob = rr * 64 + cc * 2; return st * 1024 + (ob ^ (((ob >> 9) & 1) << 5)); }
__device__ __forceinline__ void stage_rc(int b, int& R, int& C) { const int st = b / 1024, sb = b % 1024, swz = sb ^ (((sb >> 9) & 1) << 5); R = (st >> 1) * 16 + swz / 64; C = (st & 1) * 32 + (swz % 64) / 2; }
__device__ __forceinline__ int perm32(int rho) { const int n = rho >> 4, i = rho & 15; return 8 * (i >> 2) + 4 * n + (i & 3); }
struct Unit { int pm, pn; };
struct Gemm { const bf16_t* A; const bf16_t* Bt; int lda, K, acol; };
struct StaticOrder {
  int nM, nN, nwg, G, c;
  __device__ void init(int M, int N, int G_, int c_) { nM = M / BM; nN = N / BM; nwg = nM * nN; G = G_; c = c_; }
  __device__ bool next(int i, Unit& u) const {
    const long L = (long)i * G + c; if (L >= nwg) return false;
    int wgid = (int)L; { const int q = nwg / NXCD, r = nwg % NXCD, xcd = wgid % NXCD, off = wgid / NXCD; wgid = (xcd < r ? xcd * (q + 1) : r * (q + 1) + (xcd - r) * q) + off; }
    const int nig = WGM * nN, gid = wgid / nig, fm = gid * WGM, gsz = (nM - fm) < WGM ? (nM - fm) : WGM;
    u.pm = fm + ((wgid % nig) % gsz); u.pn = (wgid % nig) / gsz; return true;
  }
};
struct OrderG1 {
  StaticOrder so;
  __device__ bool next(int i, Unit& u) const {
    if (so.next(i, u)) return true;
    const long L = (long)i * so.G + so.c;
    if (L >= so.nwg && L < so.nwg + 2) { u.pm = 128 + (int)(L - so.nwg); u.pn = 2; return true; }
    return false;
  }
};

template <class Epi, class Sched>
__device__ __forceinline__ void gemm_phase(LAS unsigned char* lds, const Gemm g, const Sched& S, const Epi& E) {
  const int tid = opaque_tid(), wid = __builtin_amdgcn_readfirstlane(tid >> 6), lane = tid & 63, wr = wid >> 2, wc = wid & 3, fr = lane & 15, fq = lane >> 4;
  const int K = g.K, nt = K / BK;
  unsigned voffA[2], voffB[2];
#pragma unroll
  for (int i = 0; i < 2; ++i) { int R, C; stage_rc(tid * 16 + i * 8192, R, C); const int Rb = Epi::PERM ? ((R & ~31) + perm32(R & 31)) : R;
    voffA[i] = (unsigned)(R * g.lda + C) * 2u; voffB[i] = (unsigned)(Rb * K + C) * 2u; }
  const size_t kstep = (size_t)(BK * 2);
  const size_t hstepA = (size_t)HALF * g.lda * 2, hstepB = (size_t)HALF * K * 2;
  const size_t tstepA = 2 * hstepA, tstepB = 2 * hstepB;
  const unsigned ldsw = (unsigned)wid * 1024u;
  const int aoff = lds_byte(wr * 64 + fr, fq * 8), boff = lds_byte(wc * 32 + fr, fq * 8);
#define PG8_SA(b, h) (((b) * 2 + (h)) * HTB)
#define PG8_SB(b, h) ((4 + (b) * 2 + (h)) * HTB)
#define PG8_STAGE(bufoff, gbase, voff) do { _Pragma("unroll") for (int _i = 0; _i < 2; ++_i) \
    __builtin_amdgcn_global_load_lds((const unsigned*)((const char*)(gbase) + (voff)[_i]), (LAS unsigned*)(lds + (bufoff) + ldsw + _i * 8192), 16, 0, 0); } while (0)
#define PG8_LDA(dst, b, h) do { _Pragma("unroll") for (int m = 0; m < 4; ++m) _Pragma("unroll") for (int k = 0; k < 2; ++k) dst[m][k] = *(const LAS bf16x8*)(lds + PG8_SA(b, h) + aoff + m * 2048 + k * 1024); } while (0)
#define PG8_LDB(dst, b, h) do { _Pragma("unroll") for (int n = 0; n < 2; ++n) _Pragma("unroll") for (int k = 0; k < 2; ++k) dst[n][k] = *(const LAS bf16x8*)(lds + PG8_SB(b, h) + boff + n * 2048 + k * 1024); } while (0)
#define PG8_MMA(ai, bj, At, Bt) do { __builtin_amdgcn_s_setprio(1); _Pragma("unroll") for (int m = 0; m < 4; ++m) _Pragma("unroll") for (int n = 0; n < 2; ++n) _Pragma("unroll") for (int k = 0; k < 2; ++k) \
    acc[ai][bj][m][n] = __builtin_amdgcn_mfma_f32_16x16x32_bf16(Bt[n][k], At[m][k], acc[ai][bj][m][n], 0, 0, 0); __builtin_amdgcn_s_setprio(0); } while (0)
#define PG8_WAIT_V(n) asm volatile("s_waitcnt vmcnt(" #n ")" ::: "memory")
#define PG8_WAIT_L(n) asm volatile("s_waitcnt lgkmcnt(" #n ")" ::: "memory")
#define PG8_BAR __builtin_amdgcn_s_barrier()
#define PG8_SCHED __builtin_amdgcn_sched_barrier(0)
  Unit cur, nxt; int ui = 0;
  if (!S.next(0, cur)) return;
  f32x4 acc[2][2][4][2];
#pragma unroll
  for (int a = 0; a < 2; ++a)
#pragma unroll
    for (int b = 0; b < 2; ++b)
#pragma unroll
      for (int m = 0; m < 4; ++m)
#pragma unroll
        for (int n = 0; n < 2; ++n) acc[a][b][m][n] = (f32x4){0.f, 0.f, 0.f, 0.f};
  bf16x8 At[4][2], B0[2][2], B1[2][2];
  const char* cA = (const char*)g.A + (size_t)cur.pm * tstepA + (size_t)cur.pn * g.acol * 2; const char* cB = (const char*)g.Bt + (size_t)cur.pn * tstepB;
  PG8_STAGE(PG8_SB(0, 0), cB, voffB); PG8_STAGE(PG8_SA(0, 0), cA, voffA); PG8_STAGE(PG8_SB(0, 1), cB + hstepB, voffB); PG8_STAGE(PG8_SA(0, 1), cA + hstepA, voffA);
  if (wr == 1) PG8_BAR;
  PG8_WAIT_V(4); PG8_BAR;
  PG8_STAGE(PG8_SB(1, 0), cB + kstep, voffB); PG8_STAGE(PG8_SA(1, 0), cA + kstep, voffA); PG8_STAGE(PG8_SB(1, 1), cB + hstepB + kstep, voffB);
  PG8_WAIT_V(6); PG8_BAR;
  for (;;) {
    const bool has_next = S.next(ui + 1, nxt);
    const char* nA = has_next ? (const char*)g.A + (size_t)nxt.pm * tstepA + (size_t)nxt.pn * g.acol * 2 : cA; const char* nB = has_next ? (const char*)g.Bt + (size_t)nxt.pn * tstepB : cB;
#pragma unroll 1
    for (int t = 0; t < nt; t += 2) {
      const bool last = (t == nt - 2);
      const char* a1 = cA + (size_t)(t + 1) * kstep;
      const char* a2 = last ? nA : cA + (size_t)(t + 2) * kstep; const char* b2 = last ? nB : cB + (size_t)(t + 2) * kstep;
      const char* a3 = a2 + kstep; const char* b3 = b2 + kstep;
      PG8_LDB(B0, 0, 0); PG8_SCHED; PG8_LDA(At, 0, 0); PG8_STAGE(PG8_SA(1, 1), a1 + hstepA, voffA);
      PG8_WAIT_L(8); PG8_BAR; PG8_WAIT_L(0); PG8_MMA(0, 0, At, B0); PG8_BAR; PG8_SCHED;
      PG8_LDB(B1, 0, 1); PG8_STAGE(PG8_SB(0, 0), b2, voffB);
      PG8_BAR; PG8_WAIT_L(0); PG8_MMA(0, 1, At, B1); PG8_BAR;
      PG8_LDA(At, 0, 1); PG8_STAGE(PG8_SA(0, 0), a2, voffA);
      PG8_BAR; PG8_WAIT_L(0); PG8_MMA(1, 0, At, B0); PG8_BAR; PG8_SCHED;
      PG8_STAGE(PG8_SB(0, 1), b2 + hstepB, voffB);
      PG8_WAIT_V(6); PG8_BAR; PG8_MMA(1, 1, At, B1); PG8_BAR;
      PG8_LDB(B0, 1, 0); PG8_SCHED; PG8_LDA(At, 1, 0); PG8_STAGE(PG8_SA(0, 1), a2 + hstepA, voffA);
      PG8_WAIT_L(8); PG8_BAR; PG8_WAIT_L(0); PG8_MMA(0, 0, At, B0); PG8_BAR; PG8_SCHED;
      PG8_LDB(B1, 1, 1); PG8_STAGE(PG8_SB(1, 0), b3, voffB);
      PG8_BAR; PG8_WAIT_L(0); PG8_MMA(0, 1, At, B1); PG8_BAR;
      PG8_LDA(At, 1, 1); PG8_STAGE(PG8_SA(1, 0), a3, voffA);
      PG8_BAR; PG8_WAIT_L(0); PG8_MMA(1, 0, At, B0); PG8_BAR; PG8_SCHED;
      PG8_STAGE(PG8_SB(1, 1), b3 + hstepB, voffB);
      PG8_WAIT_V(6); PG8_BAR; PG8_MMA(1, 1, At, B1); PG8_BAR;
    }
    E(acc, cur, wr, wc, fr, fq);
    if (!has_next) break;
#pragma unroll
    for (int a = 0; a < 2; ++a)
#pragma unroll
      for (int b = 0; b < 2; ++b)
#pragma unroll
        for (int m = 0; m < 4; ++m)
#pragma unroll
          for (int n = 0; n < 2; ++n) acc[a][b][m][n] = (f32x4){0.f, 0.f, 0.f, 0.f};
    cur = nxt; cA = nA; cB = nB; ++ui;
  }
  PG8_WAIT_V(0);
  if (wr == 0) PG8_BAR;
  PG8_BAR;
#undef PG8_SA
#undef PG8_SB
#undef PG8_STAGE
#undef PG8_LDA
#undef PG8_LDB
#undef PG8_MMA
#undef PG8_WAIT_V
#undef PG8_WAIT_L
#undef PG8_BAR
#undef PG8_SCHED
}
}

struct EpiG1 {
  static constexpr bool PERM = false;
  bf16_t *Qb, *Kb, *VT, *KC, *VCT, *Ub, *GT; const float* rope;
  __device__ __forceinline__ void operator()(const f32x4 (&acc)[2][2][4][2], const pg8::Unit& u, int wr, int wc, int fr, int fq) const {
    const int pn = u.pn;
    if (u.pm >= 128) {
#pragma unroll
      for (int ai = 0; ai < 2; ++ai)
#pragma unroll
        for (int m = 0; m < 4; ++m) {
          const int tc = (u.pm - 128) * 256 + 128 * ai + 64 * wr + 16 * m + fr, b = tc >> 8, cp = tc & 255;
#pragma unroll
          for (int n = 0; n < 2; ++n) {
            const f32x4 kv = acc[ai][0][m][n]; const int cc = 32 * wc + 16 * n + 4 * fq;
            u32x2 w; w.x = pk2(kv[0], kv[1]); w.y = pk2(kv[2], kv[3]); *(u32x2*)(KC + (size_t)tc * 128 + cc) = w;
            const f32x4 vv = acc[ai][1][m][n]; const int g = cc >> 6, d = cc & 63;
#pragma unroll
            for (int j = 0; j < 4; ++j) VCT[((size_t)((b * 2 + g) * 64 + d + j)) * 256 + cp] = (bf16_t)(pk2(vv[j], 0.f) & 0xffffu);
          }
        }
      return;
    }
#pragma unroll
    for (int ai = 0; ai < 2; ++ai)
#pragma unroll
      for (int m = 0; m < 4; ++m) {
        const int t = u.pm * 256 + 128 * ai + 64 * wr + 16 * m + fr, s = t & (SEQL - 1), b = t >> 14;
        if (pn <= 2) {
          const int pos = (wc & 1) ? (s & 63) : (s >> 6);
          const f32x4 cs = *(const f32x4*)(rope + pos * 16 + 4 * fq), sn = *(const f32x4*)(rope + 4096 + pos * 16 + 4 * fq);
#pragma unroll
          for (int bj = 0; bj < 2; ++bj) {
            const f32x4 x1 = acc[ai][bj][m][0], x2 = acc[ai][bj][m][1];
            if (pn < 2) {
              const f32x4 o1 = (x1 * cs - x2 * sn) * 0.18033688f, o2 = (x1 * sn + x2 * cs) * 0.18033688f;
              bf16_t* dst = Qb + (size_t)t * 512 + pn * 256 + 128 * bj + 32 * wc + 4 * fq;
              u32x2 w; w.x = pk2(o1[0], o1[1]); w.y = pk2(o1[2], o1[3]); *(u32x2*)dst = w;
              w.x = pk2(o2[0], o2[1]); w.y = pk2(o2[2], o2[3]); *(u32x2*)(dst + 16) = w;
            } else if (bj == 0) {
              const f32x4 o1 = x1 * cs - x2 * sn, o2 = x1 * sn + x2 * cs;
              bf16_t* dst = Kb + (size_t)t * 128 + 32 * wc + 4 * fq;
              u32x2 w; w.x = pk2(o1[0], o1[1]); w.y = pk2(o1[2], o1[3]); *(u32x2*)dst = w;
              w.x = pk2(o2[0], o2[1]); w.y = pk2(o2[2], o2[3]); *(u32x2*)(dst + 16) = w;
            } else {
#pragma unroll
              for (int n = 0; n < 2; ++n) {
                const f32x4 vv = n ? x2 : x1; const int cc = 32 * wc + 16 * n + 4 * fq, g = cc >> 6, d = cc & 63;
#pragma unroll
                for (int j = 0; j < 4; ++j) VT[((size_t)((b * 2 + g) * 64 + d + j)) * SEQL + s] = (bf16_t)(pk2(vv[j], 0.f) & 0xffffu);
              }
            }
          }
        } else if (pn <= 4) {
#pragma unroll
          for (int bj = 0; bj < 2; ++bj)
#pragma unroll
            for (int n = 0; n < 2; ++n) {
              const f32x4 v = acc[ai][bj][m][n];
              u32x2 w; w.x = pk2(gelu_tanh(v[0]), gelu_tanh(v[1])); w.y = pk2(gelu_tanh(v[2]), gelu_tanh(v[3]));
              *(u32x2*)(Ub + (size_t)t * 512 + (pn - 3) * 256 + 128 * bj + 32 * wc + 16 * n + 4 * fq) = w;
            }
        } else {
          const int tb = t >> 7, q = t & 127;
#pragma unroll
          for (int bj = 0; bj < 2; ++bj)
#pragma unroll
            for (int n = 0; n < 2; ++n) {
              const f32x4 v = acc[ai][bj][m][n]; const int cc = (pn - 5) * 256 + 128 * bj + 32 * wc + 16 * n + 4 * fq, grp = cc >> 6, d = cc & 63;
#pragma unroll
              for (int j = 0; j < 4; ++j) GT[((size_t)((tb * 8 + grp) * 64 + d + j)) * 128 + q] = (bf16_t)(pk2(gelu_tanh(v[j]), 0.f) & 0xffffu);
            }
        }
      }
  }
};
struct EpiBf16 {
  static constexpr bool PERM = true;
  bf16_t* O; int ldc;
  __device__ __forceinline__ void operator()(const f32x4 (&acc)[2][2][4][2], const pg8::Unit& u, int wr, int wc, int fr, int fq) const {
    const int col0 = u.pn * 256 + wc * 32 + 8 * fq;
#pragma unroll
    for (int ai = 0; ai < 2; ++ai)
#pragma unroll
      for (int m = 0; m < 4; ++m) { bf16_t* rowp = O + (size_t)(u.pm * 256 + 128 * ai + 64 * wr + 16 * m + fr) * ldc + col0;
#pragma unroll
        for (int bj = 0; bj < 2; ++bj) { const f32x4 v0 = acc[ai][bj][m][0], v1 = acc[ai][bj][m][1];
          u32x4 w; w.x = pk2(v0[0], v0[1]); w.y = pk2(v0[2], v0[3]); w.z = pk2(v1[0], v1[1]); w.w = pk2(v1[2], v1[3]); *(u32x4*)(rowp + bj * 128) = w; } }
  }
};

struct EpiF16 {
  static constexpr bool PERM = true;
  unsigned short* O; int ldc;
  __device__ __forceinline__ void operator()(const f32x4 (&acc)[2][2][4][2], const pg8::Unit& u, int wr, int wc, int fr, int fq) const {
    const int col0 = u.pn * 256 + wc * 32 + 8 * fq;
#pragma unroll
    for (int ai = 0; ai < 2; ++ai)
#pragma unroll
      for (int m = 0; m < 4; ++m) { unsigned short* rowp = O + (size_t)(u.pm * 256 + 128 * ai + 64 * wr + 16 * m + fr) * ldc + col0;
#pragma unroll
        for (int bj = 0; bj < 2; ++bj) { const f32x4 v0 = acc[ai][bj][m][0], v1 = acc[ai][bj][m][1];
          u32x4 w; w.x = __builtin_bit_cast(unsigned, __builtin_amdgcn_cvt_pkrtz(v0[0], v0[1])); w.y = __builtin_bit_cast(unsigned, __builtin_amdgcn_cvt_pkrtz(v0[2], v0[3]));
          w.z = __builtin_bit_cast(unsigned, __builtin_amdgcn_cvt_pkrtz(v1[0], v1[1])); w.w = __builtin_bit_cast(unsigned, __builtin_amdgcn_cvt_pkrtz(v1[2], v1[3])); *(u32x4*)(rowp + bj * 128) = w; } }
  }
};

__device__ __forceinline__ void transpose_item(const float* W, int K, int N, bf16_t* WT, LAS float* scr, int item, int lane) {
  const int nblk = N / 32, kb = item / nblk, nb = item % nblk, k0 = 64 * kb, n0 = 32 * nb;
#pragma unroll 8
  for (int i = 0; i < 32; ++i) { const int kk = 2 * i + (lane >> 5); scr[kk * 33 + (lane & 31)] = W[(size_t)(k0 + kk) * N + n0 + (lane & 31)]; }
  asm volatile("s_waitcnt lgkmcnt(0)" ::: "memory");
  const int c = lane & 7;
#pragma unroll
  for (int j = 0; j < 4; ++j) { const int n = (lane >> 3) + 8 * j; const LAS float* s = scr + (8 * c) * 33 + n;
    u32x4 o; o.x = pk2(s[0 * 33], s[1 * 33]); o.y = pk2(s[2 * 33], s[3 * 33]); o.z = pk2(s[4 * 33], s[5 * 33]); o.w = pk2(s[6 * 33], s[7 * 33]);
    *(u32x4*)(WT + (size_t)(n0 + n) * K + k0 + 8 * c) = o; }
  asm volatile("s_waitcnt lgkmcnt(0)" ::: "memory");
}
__device__ __forceinline__ void convert_bf16(const float* src, bf16_t* dst, size_t n8, size_t i0, size_t stride) {
  for (size_t i = i0; i < n8; i += stride) { const f32x4 a = *(const f32x4*)(src + i * 8), b = *(const f32x4*)(src + i * 8 + 4);
    u32x4 o; o.x = pk2(a[0], a[1]); o.y = pk2(a[2], a[3]); o.z = pk2(b[0], b[1]); o.w = pk2(b[2], b[3]); *(u32x4*)(dst + i * 8) = o; }
}
__device__ __forceinline__ void convert_tables(const Params& p, int layer, int worker, int nworkers, int lane) {
  unsigned char* ws = p.ws;
  constexpr int RB = 4;
#pragma unroll 1
  for (int row0 = worker; row0 < 2 * NEXP; row0 += RB * nworkers) {
    f32x4 v[RB][4];
#pragma unroll
    for (int q = 0; q < RB; ++q) { const int row = min(row0 + q * nworkers, 2 * NEXP - 1); const int up = row >> 14, le = layer * NEXP + (row & (NEXP - 1));
      const f32x4* src = (const f32x4*)((up ? p.peer_up : p.peer_down) + (size_t)le * DM) + lane;
#pragma unroll
      for (int j = 0; j < 4; ++j) v[q][j] = src[64 * j]; }
#pragma unroll
    for (int q = 0; q < RB; ++q) { const int row = row0 + q * nworkers; if (row >= 2 * NEXP) break;
      const int up = row >> 14, e = row & (NEXP - 1), le = layer * NEXP + e;
      float am = 0.f;
#pragma unroll
      for (int j = 0; j < 4; ++j) am = fmaxf(am, fmaxf(fmaxf(fabsf(v[q][j][0]), fabsf(v[q][j][1])), fmaxf(fabsf(v[q][j][2]), fabsf(v[q][j][3]))));
      am = wave_max(am);
      if (!up || ((UP4_MASK >> layer) & 1)) {
        const float inv4 = am > 0.f ? 6.0f / am : 0.f;
        unsigned char* d4 = ws + (up ? WS_TU8 + (size_t)layer * NEXP * DM : WS_TD8 + (size_t)layer * NEXP * 512) + (size_t)e * 128 + 2 * lane;
#pragma unroll
        for (int j = 0; j < 4; ++j) { unsigned w = __builtin_amdgcn_cvt_scalef32_pk_fp4_f32(0u, v[q][j][0] * inv4, v[q][j][1] * inv4, 1.0f, 0);
          w = __builtin_amdgcn_cvt_scalef32_pk_fp4_f32(w, v[q][j][2] * inv4, v[q][j][3] * inv4, 1.0f, 1);
          *(unsigned short*)(d4 + (size_t)j * NEXP * 128) = (unsigned short)w; }
        if (lane == 0) ((float*)(ws + (up ? WS_SU : WS_SD)))[le] = am * (1.0f / 6.0f);
        continue; }
      const float inv = am > 0.f ? 448.0f / am : 0.f;
      unsigned char* dst = ws + (up ? WS_TU8 : WS_TD8) + (size_t)layer * NEXP * DM + (size_t)e * 128 + ((4 * lane) & 127);
#pragma unroll
      for (int j = 0; j < 4; ++j) { int w = __builtin_amdgcn_cvt_pk_fp8_f32(v[q][j][0] * inv, v[q][j][1] * inv, 0, false); w = __builtin_amdgcn_cvt_pk_fp8_f32(v[q][j][2] * inv, v[q][j][3] * inv, w, true);
        *(unsigned*)(dst + (size_t)(2 * j + (lane >> 5)) * NEXP * 128) = (unsigned)w; }
      if (lane == 0) ((float*)(ws + (up ? WS_SU : WS_SD)))[le] = am * (1.0f / 448.0f);
    }
  }
}

__device__ __forceinline__ void phase_prep(const Params& p, LAS unsigned char* lds) {
  const int tid = opaque_tid(), lane = tid & 63, wave = tid >> 6;
  unsigned char* ws = p.ws;
  if (blockIdx.x < 192) {
    const int layer = blockIdx.x / 96, col = (blockIdx.x % 96) * 64 + (tid & 63), kg = tid >> 6;
    const float* W = p.mod_w + (size_t)layer * DM * 6144;
    LAS float* sv = (LAS float*)(lds + 8192);
    for (int i = tid; i < 3 * DM; i += NTHREADS) sv[i] = silu(i < 2 * DM ? p.c[i] : p.c_ctx[i - 2 * DM]);
    __syncthreads();
    float a0 = 0.f, a1 = 0.f, a2 = 0.f;
#pragma unroll 8
    for (int k = kg * 128; k < kg * 128 + 128; ++k) {
      const float w = W[(size_t)k * 6144 + col];
      a0 += sv[k] * w; a1 += sv[DM + k] * w; a2 += sv[2 * DM + k] * w;
    }
    LAS float* red = (LAS float*)lds;
    red[(kg * 3 + 0) * 64 + (tid & 63)] = a0; red[(kg * 3 + 1) * 64 + (tid & 63)] = a1; red[(kg * 3 + 2) * 64 + (tid & 63)] = a2;
    __syncthreads();
    if (tid < 192) { const int v = tid >> 6, cc = tid & 63; float sacc = 0.f;
#pragma unroll
      for (int g = 0; g < 8; ++g) sacc += red[(g * 3 + v) * 64 + cc];
      const int colg = (blockIdx.x % 96) * 64 + cc; sacc += p.mod_b[layer * 6144 + colg];
      float* MOD = (float*)(ws + WS_MOD);
      if (layer == 0) MOD[v * 6144 + colg] = sacc; else if (v < 2) MOD[(3 + v) * 6144 + colg] = sacc; }
    __syncthreads();
  }
  { const int i = blockIdx.x * NTHREADS + tid; if (i < 4096) { const int pos = i >> 4, f = i & 15; const float inv = powf(10000.0f, -(float)f / 16.0f), ang = (float)pos * inv;
      float* R = (float*)(ws + WS_ROPE); R[i] = cosf(ang); R[4096 + i] = sinf(ang); } }
  { LAS float* scr = (LAS float*)(lds + 8192 + wave * 8448);
    const int gw = blockIdx.x * NWAVES + wave, NGW = gridDim.x * NWAVES;
    constexpr int I_IN = 16 * 56, I_OUT = 16 * 32, I_Q = 16 * 64, I_P = 4 * 8;
    constexpr int NITEMS = I_IN + I_OUT + 4 * I_P;
    for (int it = gw; it < NITEMS; it += NGW) {
      int r = it;
      if (r < I_IN) { transpose_item(p.attn_in_w, DM, INW, (bf16_t*)(ws + WS_WIN), scr, r, lane); continue; } r -= I_IN;
      if (r < I_OUT) { transpose_item(p.attn_out_w, DM, DM, (bf16_t*)(ws + WS_WOUT), scr, r, lane); continue; } r -= I_OUT;
      const int g = r / I_P; r -= g * I_P;
      transpose_item(p.pool_w + (size_t)g * 256 * 256, 256, 256, (bf16_t*)(ws + WS_WPOOL) + (size_t)g * 256 * 256, scr, r, lane);
    }
  }
  { LAS float* As = (LAS float*)lds; LAS float* Ss = (LAS float*)(lds + 64 * 132 * 4);
    __syncthreads();
    for (int item = blockIdx.x; item < 2 * 16 * 16; item += gridDim.x) {
      const int kb = item & 15, hp = (item >> 4) & 15, l = item >> 8, pp = hp & 1;
      __syncthreads();
      f32x4 stg[12];
#pragma unroll
      for (int u = 0; u < 4; ++u) { const int i = tid + u * NTHREADS, row = i >> 5, c4 = i & 31;
        stg[u] = *(const f32x4*)(p.peer_w_q + ((size_t)l * DM + kb * 64 + row) * 2048 + hp * 128 + c4 * 4); }
#pragma unroll
      for (int u = 0; u < 8; ++u) { const int i = tid + u * NTHREADS, row = i >> 5, c4 = i & 31;
        stg[4 + u] = *(const f32x4*)(p.peer_sub_keys + (((size_t)l * 2 + pp) * 128 + row) * 128 + c4 * 4); }
#pragma unroll
      for (int u = 0; u < 4; ++u) { const int i = tid + u * NTHREADS, row = i >> 5, c4 = i & 31; *(LAS f32x4*)(As + row * 132 + c4 * 4) = stg[u]; }
#pragma unroll
      for (int u = 0; u < 8; ++u) { const int i = tid + u * NTHREADS, row = i >> 5, c4 = i & 31; *(LAS f32x4*)(Ss + row * 132 + c4 * 4) = stg[4 + u]; }
      __syncthreads();
      { const int li = lane & 15, g = lane >> 4;
        f32x4 dacc[4];
#pragma unroll
        for (int q = 0; q < 4; ++q) dacc[q] = (f32x4){0.f, 0.f, 0.f, 0.f};
#pragma unroll
        for (int s8 = 0; s8 < 8; ++s8) {
          const f32x4 sa = *(const LAS f32x4*)(Ss + (16 * wave + li) * 132 + 32 * g + 4 * s8);
          f32x4 ab[4];
#pragma unroll
          for (int q = 0; q < 4; ++q) ab[q] = *(const LAS f32x4*)(As + (16 * q + li) * 132 + 32 * g + 4 * s8);
#pragma unroll
          for (int e = 0; e < 4; ++e)
#pragma unroll
            for (int q = 0; q < 4; ++q) dacc[q] = __builtin_amdgcn_mfma_f32_16x16x4f32(sa[e], ab[q][e], dacc[q], 0, 0, 0);
        }
        bf16_t* dstb = (bf16_t*)(ws + WS_WQ) + ((size_t)l * 2048 + hp * 128 + 16 * wave + 4 * g) * DM + kb * 64 + li;
#pragma unroll
        for (int q = 0; q < 4; ++q)
#pragma unroll
          for (int r = 0; r < 4; ++r) dstb[(size_t)r * DM + 16 * q] = (bf16_t)(pk2(dacc[q][r], 0.f) & 0xffffu);
      }
    }
    __syncthreads();
  }
  { const size_t i0 = (size_t)blockIdx.x * NTHREADS + tid, stride = (size_t)gridDim.x * NTHREADS;
    convert_bf16(p.gmlp_w_s, (bf16_t*)(ws + WS_WS), 8 * 128 * 128 / 8, i0, stride);
  }
  convert_tables(p, 0, blockIdx.x * NWAVES + wave, gridDim.x * NWAVES, lane);
}

__device__ __forceinline__ void resid_norm_phase(const Params& p, int layer) {
  unsigned char* ws = p.ws;
  const int tid = opaque_tid(), lane = tid & 63, wave = tid >> 6;
  const int gw = blockIdx.x * NWAVES + wave, NGW = gridDim.x * NWAVES;
  const float* MOD = (const float*)(ws + WS_MOD); bf16_t* H = (bf16_t*)(ws + WS_H); const bf16_t* Y = (const bf16_t*)(ws + WS_Y);
  bf16_t* XR = (bf16_t*)(ws + WS_XR); const float* ng = p.norm2_g + layer * DM;
  constexpr int RB = 4;
#pragma unroll 1
  for (int b = 0; b < NB; ++b) {
    const float* m = MOD + (size_t)(layer == 0 ? b : 3 + b) * 6144;
    f32x4 G[4], A[4], B[4];
#pragma unroll
    for (int j = 0; j < 4; ++j) { G[j] = ((const f32x4*)(m + 2 * DM))[lane + 64 * j]; if (layer == 1) G[j] = G[j] * ((const f32x4*)p.pool_scale)[lane + 64 * j];
      A[j] = ((const f32x4*)ng)[lane + 64 * j] * (((const f32x4*)(m + 4 * DM))[lane + 64 * j] + 1.0f); B[j] = ((const f32x4*)(m + 3 * DM))[lane + 64 * j]; }
#pragma unroll 1
    for (int r0 = b * SEQL + gw; r0 < (b + 1) * SEQL; r0 += RB * NGW) {
      f32x4 v[RB][4]; u32x2 yw[RB][4];
#pragma unroll
      for (int q = 0; q < RB; ++q) { const int r = min(r0 + q * NGW, (b + 1) * SEQL - 1);
        const u32x2* yr = (const u32x2*)(Y + (size_t)r * DM) + lane;
        if (layer == 0) { const f32x4* xr = (const f32x4*)(p.x + (size_t)r * DM) + lane;
#pragma unroll
          for (int j = 0; j < 4; ++j) { v[q][j] = xr[64 * j]; yw[q][j] = yr[64 * j]; } }
        else { const u32x2* xr = (const u32x2*)(XR + (size_t)r * DM) + lane;
#pragma unroll
          for (int j = 0; j < 4; ++j) { const u32x2 w = xr[64 * j]; v[q][j] = (f32x4){bf_lo(w.x), bf_hi(w.x), bf_lo(w.y), bf_hi(w.y)}; yw[q][j] = yr[64 * j]; } } }
#pragma unroll
      for (int q = 0; q < RB; ++q) { const int r = r0 + q * NGW; if (r >= (b + 1) * SEQL) break;
        float ss = 0.f;
#pragma unroll
        for (int j = 0; j < 4; ++j) { const f32x4 yy = (f32x4){bf_lo(yw[q][j].x), bf_hi(yw[q][j].x), bf_lo(yw[q][j].y), bf_hi(yw[q][j].y)};
          v[q][j] = v[q][j] + G[j] * yy; ss += (v[q][j][0] * v[q][j][0] + v[q][j][1] * v[q][j][1]) + (v[q][j][2] * v[q][j][2] + v[q][j][3] * v[q][j][3]); }
        const float rr = rsqrtf(wave_sum(ss) * (1.0f / DM) + 1e-6f);
        u32x2* xo = (u32x2*)(XR + (size_t)r * DM) + lane; u32x2* o8 = (u32x2*)(H + (size_t)r * DM) + lane;
#pragma unroll
        for (int j = 0; j < 4; ++j) { { u32x2 w; w.x = pk2(v[q][j][0], v[q][j][1]); w.y = pk2(v[q][j][2], v[q][j][3]); xo[64 * j] = w; }
          const f32x4 y = (v[q][j] * rr) * A[j] + B[j]; u32x2 w; w.x = pk2(y[0], y[1]); w.y = pk2(y[2], y[3]); o8[64 * j] = w;
          float am = fmaxf(fmaxf(fabsf(y[0]), fabsf(y[1])), fmaxf(fabsf(y[2]), fabsf(y[3])));
          am = fmaxf(am, dppf<0xB1>(am)); am = fmaxf(am, dppf<0x4E>(am)); am = fmaxf(am, dppf<0x141>(am));
          const int s0 = max((int)(__float_as_uint(am) >> 23), 64) - 1;
          const float inv0 = __uint_as_float((unsigned)(254 - s0) << 23);
          const f32x2 fa = (f32x2){y[0], y[1]} * inv0, fb = (f32x2){y[2], y[3]} * inv0;
          unsigned w0 = __builtin_amdgcn_cvt_scalef32_pk_fp4_f32(0u, fa.x, fa.y, 1.0f, 0); w0 = __builtin_amdgcn_cvt_scalef32_pk_fp4_f32(w0, fb.x, fb.y, 1.0f, 1);
          const f32x2 ra = (fa - __builtin_amdgcn_cvt_scalef32_pk_f32_fp4(w0, 1.0f, 0)) * 4.0f, rb = (fb - __builtin_amdgcn_cvt_scalef32_pk_f32_fp4(w0, 1.0f, 1)) * 4.0f;
          unsigned w1 = __builtin_amdgcn_cvt_scalef32_pk_fp4_f32(0u, ra.x, ra.y, 1.0f, 0); w1 = __builtin_amdgcn_cvt_scalef32_pk_fp4_f32(w1, rb.x, rb.y, 1.0f, 1);
          unsigned char* hq = ws + WS_HQ + (size_t)r * 1024 + (8 * j + (lane >> 3)) * 16 + 2 * (lane & 7);
          *(unsigned short*)hq = (unsigned short)w0; *(unsigned short*)(hq + 512) = (unsigned short)w1;
          if ((lane & 7) == 0) (ws + WS_HS)[(size_t)r * 32 + 8 * j + (lane >> 3)] = (unsigned char)s0; }
      }
    }
  }
}

__device__ __forceinline__ int xcd_item(int rnd, int nitems) {
  const int G = gridDim.x;
  if ((G & 7) || (nitems & 7)) return (int)blockIdx.x + rnd * G;
  const int per = nitems >> 3, nb = G >> 3, j = (int)blockIdx.x >> 3, i = j + rnd * nb;
  return i < per ? ((int)blockIdx.x & 7) * per + i : nitems;
}
constexpr int KS_STRIDE = 144, VS_STRIDE = 272;
__device__ __forceinline__ void attn_phase(const Params& p, LAS unsigned char* lds) {
  unsigned char* ws = p.ws;
  const bf16_t* Qb = (const bf16_t*)(ws + WS_QB); const bf16_t* Kb = (const bf16_t*)(ws + WS_KB); const bf16_t* VT = (const bf16_t*)(ws + WS_VT);
  const bf16_t* KC = (const bf16_t*)(ws + WS_KC); const bf16_t* VCT = (const bf16_t*)(ws + WS_VCT); bf16_t* CAT = (bf16_t*)(ws + WS_CAT);
  const int tid = opaque_tid(), lane = tid & 63, wave = tid >> 6, fr = lane & 15, G = lane >> 4;
  LAS unsigned char* Ks = lds; LAS unsigned char* Vs = lds + 128 * KS_STRIDE;
  for (int rnd = 0, item = xcd_item(0, 1024); item < 1024; item = xcd_item(++rnd, 1024)) {
    const int half = item & 1, g = (item >> 1) & 1, n = (item >> 2) & 127, b = item >> 9;
    const int hq = g * 4 + half * 2 + (wave >> 2), q0 = n * 128 + (wave & 3) * 32;
    bf16x8 Qf[2][2];
#pragma unroll
    for (int qt = 0; qt < 2; ++qt)
#pragma unroll
      for (int ks = 0; ks < 2; ++ks) Qf[qt][ks] = *(const bf16x8*)(Qb + (size_t)(b * SEQL + q0 + qt * 16 + fr) * 512 + hq * 64 + ks * 32 + 8 * G);
    const float sink = p.attn_sink[hq] * 1.44269504f;
    float m_run[2] = {sink, sink}, l_run[2] = {1.0f, 1.0f};
    f32x4 O[4][2];
#pragma unroll
    for (int dt = 0; dt < 4; ++dt) { O[dt][0] = (f32x4){0.f, 0.f, 0.f, 0.f}; O[dt][1] = (f32x4){0.f, 0.f, 0.f, 0.f}; }
    u32x4 kreg[2], vreg[2];
    auto fetch = [&](int kb) {
      const int tile = n - 1 + kb;
#pragma unroll
      for (int i = 0; i < 2; ++i) {
        const int pc = tid + i * 512;
        { const int key = pc >> 3, ch = pc & 7;
          const bf16_t* src = (kb < 3) ? Kb + (size_t)(b * SEQL + tile * 128 + key) * 128 + g * 64 + ch * 8 : KC + (size_t)(b * CTXL + (kb - 3) * 128 + key) * 128 + g * 64 + ch * 8;
          kreg[i] = *(const u32x4*)src; }
        { const int d = pc >> 4, ch = pc & 15;
          const bf16_t* src = (kb < 3) ? VT + (size_t)((b * 2 + g) * 64 + d) * SEQL + tile * 128 + ch * 8 : VCT + (size_t)((b * 2 + g) * 64 + d) * CTXL + (kb - 3) * 128 + ch * 8;
          vreg[i] = *(const u32x4*)src; }
      }
    };
    const int kb_first = (n == 0) ? 1 : 0;
    fetch(kb_first);
    for (int kb = kb_first; kb < 5; ++kb) {
      const int tile = n - 1 + kb;
      if (kb == 2 && tile >= SEQL / 128) continue;
      __syncthreads();
#pragma unroll
      for (int i = 0; i < 2; ++i) { const int pc = tid + i * 512;
        *(LAS u32x4*)(Ks + (pc >> 3) * KS_STRIDE + (pc & 7) * 16) = kreg[i];
        *(LAS u32x4*)(Vs + (pc >> 4) * VS_STRIDE + (pc & 15) * 16) = vreg[i]; }
      { int kn = kb + 1; if (kn == 2 && n + 1 >= SEQL / 128) kn = 3; if (kn < 5) fetch(kn); }
      __syncthreads();
      f32x4 S[8][2];
#pragma unroll
      for (int kt = 0; kt < 8; ++kt) {
        S[kt][0] = (f32x4){0.f, 0.f, 0.f, 0.f}; S[kt][1] = (f32x4){0.f, 0.f, 0.f, 0.f};
#pragma unroll
        for (int ks = 0; ks < 2; ++ks) {
          const bf16x8 kf = *(const LAS bf16x8*)(Ks + (16 * kt + fr) * KS_STRIDE + ks * 64 + G * 16);
          S[kt][0] = __builtin_amdgcn_mfma_f32_16x16x32_bf16(kf, Qf[0][ks], S[kt][0], 0, 0, 0);
          S[kt][1] = __builtin_amdgcn_mfma_f32_16x16x32_bf16(kf, Qf[1][ks], S[kt][1], 0, 0, 0);
        }
      }
      if (kb == 0 || kb == 2) {
#pragma unroll
        for (int qt = 0; qt < 2; ++qt) { const int qpos = q0 + qt * 16 + fr;
#pragma unroll
          for (int kt = 0; kt < 8; ++kt)
#pragma unroll
            for (int r = 0; r < 4; ++r) { const int kpos = tile * 128 + 16 * kt + 4 * G + r; const bool ok = (kb == 0) ? (kpos >= qpos - 128) : (kpos <= qpos + 128);
              S[kt][qt][r] = ok ? S[kt][qt][r] : -INFINITY; } }
      }
      bf16x8 Pf[4][2];
#pragma unroll
      for (int qt = 0; qt < 2; ++qt) {
        float mx = S[0][qt][0];
#pragma unroll
        for (int kt = 0; kt < 8; ++kt)
#pragma unroll
          for (int r = 0; r < 4; ++r) mx = fmaxf(mx, S[kt][qt][r]);
        mx = xor32_max(xor16_max(mx));
        const float m_new = fmaxf(m_run[qt], mx), alpha = __builtin_amdgcn_exp2f(m_run[qt] - m_new);
        float rs = 0.f;
#pragma unroll
        for (int kt = 0; kt < 8; ++kt)
#pragma unroll
          for (int r = 0; r < 4; ++r) { const float e = __builtin_amdgcn_exp2f(S[kt][qt][r] - m_new); S[kt][qt][r] = e; rs += e; }
        rs = swap16_sum(rs, rs); rs = swap32_sum(rs, rs);
        l_run[qt] = l_run[qt] * alpha + rs; m_run[qt] = m_new;
#pragma unroll
        for (int dt = 0; dt < 4; ++dt) O[dt][qt] = O[dt][qt] * alpha;
#pragma unroll
        for (int s = 0; s < 4; ++s) { u32x4 w; w.x = pk2(S[2 * s][qt][0], S[2 * s][qt][1]); w.y = pk2(S[2 * s][qt][2], S[2 * s][qt][3]); w.z = pk2(S[2 * s + 1][qt][0], S[2 * s + 1][qt][1]); w.w = pk2(S[2 * s + 1][qt][2], S[2 * s + 1][qt][3]);
          Pf[s][qt] = *(bf16x8*)&w; }
      }
#pragma unroll
      for (int dt = 0; dt < 4; ++dt)
#pragma unroll
        for (int s = 0; s < 4; ++s) {
          const u32x2 v0 = *(const LAS u32x2*)(Vs + (16 * dt + fr) * VS_STRIDE + (32 * s + 4 * G) * 2), v1 = *(const LAS u32x2*)(Vs + (16 * dt + fr) * VS_STRIDE + (32 * s + 16 + 4 * G) * 2);
          u32x4 w; w.x = v0.x; w.y = v0.y; w.z = v1.x; w.w = v1.y; const bf16x8 vf = *(bf16x8*)&w;
          O[dt][0] = __builtin_amdgcn_mfma_f32_16x16x32_bf16(vf, Pf[s][0], O[dt][0], 0, 0, 0);
          O[dt][1] = __builtin_amdgcn_mfma_f32_16x16x32_bf16(vf, Pf[s][1], O[dt][1], 0, 0, 0);
        }
    }
#pragma unroll
    for (int qt = 0; qt < 2; ++qt) { const float inv = 1.0f / l_run[qt];
#pragma unroll
      for (int dt = 0; dt < 4; ++dt) { const f32x4 o = O[dt][qt] * inv; u32x2 w; w.x = pk2(o[0], o[1]); w.y = pk2(o[2], o[3]);
        *(u32x2*)(CAT + (size_t)(b * SEQL + q0 + qt * 16 + fr) * DM + hq * 64 + 16 * dt + 4 * G) = w; } }
  }
  __syncthreads();
}

__device__ __forceinline__ void gmlp_phase(const Params& p, LAS unsigned char* lds) {
  unsigned char* ws = p.ws;
  const bf16_t* GT = (const bf16_t*)(ws + WS_GT); const bf16_t* Ub = (const bf16_t*)(ws + WS_UB); const bf16_t* WSb = (const bf16_t*)(ws + WS_WS); bf16_t* CAT = (bf16_t*)(ws + WS_CAT);
  const int tid = opaque_tid(), lane = tid & 63, wave = tid >> 6, fr = lane & 15, G = lane >> 4;
  LAS unsigned char* Gs = lds; LAS float* mu = (LAS float*)(lds + 64 * VS_STRIDE); LAS float* rstd = mu + 128;
  for (int item = blockIdx.x; item < 2048; item += gridDim.x) {
    const int tb = item >> 3, grp = item & 7;
    __syncthreads();
#pragma unroll
    for (int i = 0; i < 2; ++i) { const int pc = tid + i * 512, d = pc >> 4, ch = pc & 15;
      *(LAS u32x4*)(Gs + d * VS_STRIDE + ch * 16) = *(const u32x4*)(GT + (size_t)((tb * 8 + grp) * 64 + d) * 128 + ch * 8); }
    __syncthreads();
    if (tid < 128) { float s = 0.f, s2 = 0.f;
      for (int d = 0; d < 64; ++d) { const float v = __uint_as_float((unsigned)(*(const LAS bf16_t*)(Gs + d * VS_STRIDE + tid * 2)) << 16); s += v; }
      const float mean = s * (1.0f / 64.0f);
      for (int d = 0; d < 64; ++d) { const float v = __uint_as_float((unsigned)(*(const LAS bf16_t*)(Gs + d * VS_STRIDE + tid * 2)) << 16) - mean; s2 += v * v; }
      mu[tid] = mean; rstd[tid] = rsqrtf(s2 * (1.0f / 64.0f) + 1e-6f); }
    __syncthreads();
#pragma unroll
    for (int i = 0; i < 8; ++i) { const int e = tid + i * 512, d = e >> 6, qp = e & 63;
      LAS unsigned* wp = (LAS unsigned*)(Gs + d * VS_STRIDE + qp * 4); const unsigned w = *wp;
      *wp = pk2((bf_lo(w) - mu[2 * qp]) * rstd[2 * qp], (bf_hi(w) - mu[2 * qp + 1]) * rstd[2 * qp + 1]); }
    __syncthreads();
    f32x4 acc[4];
#pragma unroll
    for (int dt = 0; dt < 4; ++dt) acc[dt] = (f32x4){0.f, 0.f, 0.f, 0.f};
    const int prow = 16 * wave + fr;
#pragma unroll
    for (int ks = 0; ks < 4; ++ks) {
      const bf16x8 wf = *(const bf16x8*)(WSb + (size_t)(grp * 128 + prow) * 128 + ks * 32 + 8 * G);
#pragma unroll
      for (int dt = 0; dt < 4; ++dt) { const bf16x8 xf = *(const LAS bf16x8*)(Gs + (16 * dt + fr) * VS_STRIDE + ks * 64 + G * 16);
        acc[dt] = __builtin_amdgcn_mfma_f32_16x16x32_bf16(xf, wf, acc[dt], 0, 0, 0); }
    }
    const float bias = p.gmlp_b_s[grp * 128 + prow]; const size_t t = (size_t)tb * 128 + prow;
#pragma unroll
    for (int dt = 0; dt < 4; ++dt) { const u32x2 uu = *(const u32x2*)(Ub + t * 512 + grp * 64 + 16 * dt + 4 * G);
      u32x2 w; w.x = pk2(bf_lo(uu.x) * (acc[dt][0] + bias), bf_hi(uu.x) * (acc[dt][1] + bias)); w.y = pk2(bf_lo(uu.y) * (acc[dt][2] + bias), bf_hi(uu.y) * (acc[dt][3] + bias));
      *(u32x2*)(CAT + t * DM + 512 + grp * 64 + 16 * dt + 4 * G) = w; }
  }
  __syncthreads();
}

__device__ __forceinline__ void bitonic_merge16_desc(float (&v)[16]) {
#pragma unroll
  for (int j = 8; j > 0; j >>= 1)
#pragma unroll
    for (int i = 0; i < 16; ++i) { const int l = i ^ j; if (l > i) { const float a = v[i], b = v[l]; v[i] = fmaxf(a, b); v[l] = fminf(a, b); } }
}
__device__ __forceinline__ void merge_top16(float (&a)[16], const float (&b)[16]) {
#pragma unroll
  for (int i = 0; i < 16; ++i) a[i] = fmaxf(a[i], b[15 - i]);
  bitonic_merge16_desc(a);
}
__device__ __forceinline__ float clr(float v, unsigned m) { return __uint_as_float(__float_as_uint(v) & ~m); }
__device__ __forceinline__ float cand(const float (&f0)[16], const float (&f1)[16], int a, int b) { return __uint_as_float((__float_as_uint(f0[a] + f1[b]) & ~0xffu) | (unsigned)(a * 16 + b)); }

__device__ __forceinline__ void ce_desc(float& a, float& b) { const float mx = fmaxf(a, b), mn = fminf(a, b); a = mx; b = mn; }
__device__ __forceinline__ void oe_sort16_desc(float (&v)[16]) {
  constexpr unsigned char N[63][2] = {{0,1}, {2,3}, {0,2}, {1,3}, {1,2}, {4,5}, {6,7}, {4,6}, {5,7}, {5,6}, {0,4}, {2,6}, {2,4}, {1,5}, {3,7}, {3,5}, {1,2}, {3,4}, {5,6}, {8,9}, {10,11}, {8,10}, {9,11}, {9,10}, {12,13}, {14,15}, {12,14}, {13,15}, {13,14}, {8,12}, {10,14}, {10,12}, {9,13}, {11,15}, {11,13}, {9,10}, {11,12}, {13,14}, {0,8}, {4,12}, {4,8}, {2,10}, {6,14}, {6,10}, {2,4}, {6,8}, {10,12}, {1,9}, {5,13}, {5,9}, {3,11}, {7,15}, {7,11}, {3,5}, {7,9}, {11,13}, {1,2}, {3,4}, {5,6}, {7,8}, {9,10}, {11,12}, {13,14}};
#pragma unroll
  for (int c = 0; c < 63; ++c) ce_desc(v[N[c][0]], v[N[c][1]]);
}
__device__ __forceinline__ float f16lo(unsigned w) { return (float)__builtin_bit_cast(_Float16, (unsigned short)(w & 0xffffu)); }
__device__ __forceinline__ float f16hi(unsigned w) { return (float)__builtin_bit_cast(_Float16, (unsigned short)(w >> 16)); }

__device__ __forceinline__ void topk_phase(const Params& p, LAS unsigned char* lds, int layer) {
  unsigned char* ws = p.ws;
  const unsigned short* SC = (const unsigned short*)(ws + WS_QP);
  unsigned short* IDX = (unsigned short*)(ws + WS_IDX); bf16_t* A1 = (bf16_t*)(ws + WS_GW); bf16_t* A2 = A1 + (size_t)NT * 128;
  const float* SD = (const float*)(ws + WS_SD) + layer * NEXP; const float* SU = (const float*)(ws + WS_SU) + layer * NEXP;
  const int tid = opaque_tid(), lane = tid & 63, wave = tid >> 6;
  LAS unsigned char* wl = lds + wave * 16384;
  const int srow = lane >> 4, sch = lane & 15;
  const int sw = lane & 15;
  const int nunits = NT / 8, ustride = gridDim.x * NWAVES;
  __syncthreads();
  u32x4 buf[16];
  int u = blockIdx.x * NWAVES + wave;
  if (u < nunits) {
#pragma unroll
    for (int i = 0; i < 16; ++i) { const int row = 4 * i + srow; buf[i] = *(const u32x4*)(SC + (size_t)(u * 8 + (row >> 3)) * 2048 + (row & 7) * 256 + sch * 8); }
  }
#pragma unroll 1
  for (; u < nunits; u += ustride) {
    const int t0 = u * 8;
    float s0[16], s1[16];
#pragma unroll
    for (int pp = 0; pp < 2; ++pp) {
#pragma unroll
      for (int i = 0; i < 16; ++i) { const int row = 4 * i + srow; *(LAS u32x4*)(wl + row * 256 + ((sch ^ (row & 15)) * 16)) = buf[i]; }
      { const int un = pp == 0 ? u : min(u + ustride, nunits - 1), pn = pp ^ 1;
#pragma unroll
        for (int i = 0; i < 16; ++i) { const int row = 4 * i + srow; buf[i] = *(const u32x4*)(SC + (size_t)(un * 8 + (row >> 3)) * 2048 + (row & 7) * 256 + pn * 128 + sch * 8); } }
      float top[16];
#pragma unroll
      for (int c = 0; c < 8; ++c) {
        const u32x4 w0 = *(const LAS u32x4*)(wl + lane * 256 + (((2 * c) ^ sw) * 16)), w1 = *(const LAS u32x4*)(wl + lane * 256 + (((2 * c + 1) ^ sw) * 16));
        float ch[16];
#pragma unroll
        for (int j = 0; j < 4; ++j) {
          ch[2 * j]         = __uint_as_float((w0[j] << 16) | (unsigned)(16 * c + 2 * j));
          ch[2 * j + 1]     = __uint_as_float((w0[j] & 0xffff0000u) | (unsigned)(16 * c + 2 * j + 1));
          ch[8 + 2 * j]     = __uint_as_float((w1[j] << 16) | (unsigned)(16 * c + 8 + 2 * j));
          ch[8 + 2 * j + 1] = __uint_as_float((w1[j] & 0xffff0000u) | (unsigned)(16 * c + 8 + 2 * j + 1)); }
        oe_sort16_desc(ch);
        if (c == 0) {
#pragma unroll
          for (int i = 0; i < 16; ++i) top[i] = ch[i];
        } else merge_top16(top, ch);
      }
#pragma unroll
      for (int i = 0; i < 16; ++i) { if (pp == 0) s0[i] = top[i]; else s1[i] = top[i]; }
    }
#pragma unroll
    for (int i = 0; i < 16; ++i) { *(LAS float*)(wl + lane * 256 + ((i ^ sw) * 4)) = s0[i]; *(LAS float*)(wl + lane * 256 + 64 + ((i ^ sw) * 4)) = s1[i]; }
    float f0[16], f1[16];
#pragma unroll
    for (int i = 0; i < 16; ++i) { f0[i] = f16hi(__float_as_uint(s0[i])); f1[i] = f16hi(__float_as_uint(s1[i])); }
    float top[16];
#pragma unroll
    for (int b = 0; b < 16; ++b) top[b] = cand(f0, f1, 0, b);
    { float l1[16] = {cand(f0, f1, 1, 0), cand(f0, f1, 1, 1), cand(f0, f1, 1, 2), cand(f0, f1, 1, 3), cand(f0, f1, 1, 4), cand(f0, f1, 1, 5), cand(f0, f1, 1, 6), cand(f0, f1, 1, 7),
                      cand(f0, f1, 2, 0), cand(f0, f1, 2, 1), cand(f0, f1, 2, 2), cand(f0, f1, 2, 3), cand(f0, f1, 2, 4), cand(f0, f1, 3, 0), cand(f0, f1, 3, 1), cand(f0, f1, 3, 2)};
      oe_sort16_desc(l1); merge_top16(top, l1); }
    { float l2[16] = {cand(f0, f1, 3, 3), cand(f0, f1, 4, 0), cand(f0, f1, 4, 1), cand(f0, f1, 4, 2), cand(f0, f1, 5, 0), cand(f0, f1, 5, 1), cand(f0, f1, 6, 0), cand(f0, f1, 6, 1),
                      cand(f0, f1, 7, 0), cand(f0, f1, 7, 1), cand(f0, f1, 8, 0), cand(f0, f1, 9, 0), cand(f0, f1, 10, 0), cand(f0, f1, 11, 0), cand(f0, f1, 12, 0), cand(f0, f1, 13, 0)};
      oe_sort16_desc(l2); merge_top16(top, l2); }
    { float x = cand(f0, f1, 14, 0), y = cand(f0, f1, 15, 0); ce_desc(x, y); top[15] = fmaxf(top[15], x); top[14] = fmaxf(top[14], y); }
    float mx = clr(top[0], 255u);
#pragma unroll
    for (int i = 1; i < 16; ++i) mx = fmaxf(mx, clr(top[i], 255u));
    float e[16]; float sum = 0.f;
#pragma unroll
    for (int i = 0; i < 16; ++i) { e[i] = __expf(clr(top[i], 255u) - mx); sum += e[i]; }
    const float inv = 1.0f / sum;
    unsigned ex[16];
#pragma unroll
    for (int i = 0; i < 16; ++i) { const unsigned code = __float_as_uint(top[i]) & 255u; const unsigned a = code >> 4, b = code & 15u;
      const unsigned e0 = __float_as_uint(*(const LAS float*)(wl + lane * 256 + ((a ^ sw) * 4))) & 127u, e1 = __float_as_uint(*(const LAS float*)(wl + lane * 256 + 64 + ((b ^ sw) * 4))) & 127u;
      ex[i] = e0 * 128u + e1; }
    const size_t ob = (size_t)(t0 + (lane >> 3)) * 128 + (lane & 7) * 16;
    u32x4 iw0, iw1; iw0.x = ex[0] | (ex[1] << 16); iw0.y = ex[2] | (ex[3] << 16); iw0.z = ex[4] | (ex[5] << 16); iw0.w = ex[6] | (ex[7] << 16);
    iw1.x = ex[8] | (ex[9] << 16); iw1.y = ex[10] | (ex[11] << 16); iw1.z = ex[12] | (ex[13] << 16); iw1.w = ex[14] | (ex[15] << 16);
    *(u32x4*)(IDX + ob) = iw0; *(u32x4*)(IDX + ob + 8) = iw1;
    float sdv[16], suv[16];
#pragma unroll
    for (int i = 0; i < 16; ++i) { sdv[i] = SD[ex[i]]; suv[i] = SU[ex[i]]; }
    u32x4 a1w0, a1w1, a2w0, a2w1;
#pragma unroll
    for (int j = 0; j < 4; ++j) { a1w0[j] = pk2(sdv[2 * j], sdv[2 * j + 1]); a1w1[j] = pk2(sdv[8 + 2 * j], sdv[8 + 2 * j + 1]);
      a2w0[j] = pk2(e[2 * j] * inv * suv[2 * j], e[2 * j + 1] * inv * suv[2 * j + 1]); a2w1[j] = pk2(e[8 + 2 * j] * inv * suv[8 + 2 * j], e[8 + 2 * j + 1] * inv * suv[8 + 2 * j + 1]); }
    *(u32x4*)(A1 + ob) = a1w0; *(u32x4*)(A1 + ob + 8) = a1w1; *(u32x4*)(A2 + ob) = a2w0; *(u32x4*)(A2 + ob + 8) = a2w1;
  }
  __syncthreads();
}


struct PeerIdx { int v[16]; };
__device__ __forceinline__ PeerIdx peer_load_idx(const unsigned short* IDX, int t, int r) {
  PeerIdx o; const int tt = t < NT ? t : NT - 1;
#pragma unroll
  for (int j = 0; j < 2; ++j) { const u32x4 q = *(const u32x4*)(IDX + (size_t)tt * 128 + r * 16 + 8 * j);
#pragma unroll
    for (int k = 0; k < 4; ++k) { o.v[8 * j + 2 * k] = (int)(q[k] & 0xffffu); o.v[8 * j + 2 * k + 1] = (int)(q[k] >> 16); } }
  return o;
}
struct PeerRows { u32x4 d[16]; };
__device__ __forceinline__ PeerRows peer_gather(const unsigned char* T, const PeerIdx& ix, unsigned laneoff) {
  PeerRows o;
#pragma unroll
  for (int i = 0; i < 16; ++i) o.d[i] = *(const u32x4*)(T + (((unsigned)ix.v[i] << 7) + laneoff));
  return o;
}
typedef int i32x8 __attribute__((ext_vector_type(8)));
struct PeerA { u32x4 v; int scale; };
__device__ __forceinline__ PeerA peer_build_a(const u32x4 h0, const u32x4 h1, const u32x4 h2, const u32x4 h3, bool stage1, bool live) {
  f32x2 f[16];
#pragma unroll
  for (int j = 0; j < 4; ++j) { f[j] = (f32x2){bf_lo(h0[j]), bf_hi(h0[j])}; f[4 + j] = (f32x2){bf_lo(h1[j]), bf_hi(h1[j])};
    f[8 + j] = (f32x2){bf_lo(h2[j]), bf_hi(h2[j])}; f[12 + j] = (f32x2){bf_lo(h3[j]), bf_hi(h3[j])}; }
  float am = 0.f;
#pragma unroll
  for (int j = 0; j < 16; ++j) am = fmaxf(am, fmaxf(fabsf(f[j].x), fabsf(f[j].y)));
  const int eb = max((int)(__builtin_bit_cast(unsigned, am) >> 23), 64);
  const int s0 = eb - 1;
  const float inv0 = __builtin_bit_cast(float, (unsigned)(254 - s0) << 23);
  PeerA o; u32x4 q0, q1;
#pragma unroll
  for (int j = 0; j < 4; ++j) { unsigned w0 = 0u, w1 = 0u;
#define PEER_A_BYTE(b) { const f32x2 fs = f[4 * j + b] * inv0; \
      w0 = __builtin_amdgcn_cvt_scalef32_pk_fp4_f32(w0, fs.x, fs.y, 1.0f, b); \
      const f32x2 d = __builtin_amdgcn_cvt_scalef32_pk_f32_fp4(w0, 1.0f, b); \
      const f32x2 rs = (fs - d) * 4.0f; \
      w1 = __builtin_amdgcn_cvt_scalef32_pk_fp4_f32(w1, rs.x, rs.y, 1.0f, b); }
    PEER_A_BYTE(0) PEER_A_BYTE(1) PEER_A_BYTE(2) PEER_A_BYTE(3)
#undef PEER_A_BYTE
    q0[j] = w0; q1[j] = w1; }
#pragma unroll
  for (int j = 0; j < 4; ++j) o.v[j] = live ? (stage1 ? q1[j] : q0[j]) : 0u;
  o.scale = stage1 ? s0 - 2 : s0;
  return o;
}
__device__ __forceinline__ void peer_down_token(const PeerRows& R, const PeerA A, bf16_t* dst, bool diag, bool b0, bool b1) {
  float E[32];
  const f32x4 z = (f32x4){0.f, 0.f, 0.f, 0.f};
  const i32x8 a = (i32x8){(int)A.v[0], (int)A.v[1], (int)A.v[2], (int)A.v[3], 0, 0, 0, 0};
#pragma unroll
  for (int g = 0; g < 16; ++g) {
    const i32x8 b = (i32x8){(int)R.d[g][0], (int)R.d[g][1], (int)R.d[g][2], (int)R.d[g][3], 0, 0, 0, 0};
    const f32x4 d = __builtin_amdgcn_mfma_scale_f32_16x16x128_f8f6f4(a, b, z, 4  , 4  , 0, A.scale, 0, 0x7f7f7f7f);
    E[2 * g] = diag ? d[0] + d[1] : 0.f; E[2 * g + 1] = diag ? d[2] + d[3] : 0.f; }
  float Rr[8], S[4], T[2];
#pragma unroll
  for (int G = 0; G < 8; ++G)
    Rr[G] = swap32_sum(swap16_sum(E[2 * G], E[2 * G + 1]), swap16_sum(E[2 * (G + 8)], E[2 * (G + 8) + 1]));
#pragma unroll
  for (int g0 = 0; g0 < 2; ++g0)
#pragma unroll
    for (int g2 = 0; g2 < 2; ++g2) { const float lo = Rr[g0 + 4 * g2], hi = Rr[g0 + 2 + 4 * g2];
      S[g0 + 2 * g2] = (b0 ? hi : lo) + dppf<0xB1>(b0 ? lo : hi); }
#pragma unroll
  for (int g0 = 0; g0 < 2; ++g0) T[g0] = (b1 ? S[g0 + 2] : S[g0]) + dppf<0x4E>(b1 ? S[g0] : S[g0 + 2]);
  *(unsigned*)dst = pk2(T[0], T[1]);
}
__device__ __forceinline__ void peer_down_phase(const Params& p, int layer) {
  unsigned char* ws = p.ws;
  const int tid = opaque_tid(), lane = tid & 63, wave = tid >> 6, kg = lane >> 4, m = lane & 15, u = (lane >> 2) & 3, v = lane & 3;
  const int x = blockIdx.x & 7, rank = blockIdx.x >> 3, nslot = (gridDim.x >> 3) * NWAVES;
  if (rank >= (int)(gridDim.x >> 3)) return;
  const int sl = x & 3, te = ((x >> 2) + 1) * (NT / 2);
  const int q = 2 * u + (kg >> 1);
  const unsigned short* IDX = (const unsigned short*)(ws + WS_IDX);
  const unsigned char* TD = ws + WS_TD8 + (size_t)layer * NEXP * 512 + (size_t)sl * NEXP * 128; const unsigned laneoff = 16 * (4 * (kg & 1) + v);
  bf16_t* PART = (bf16_t*)(ws + WS_PART) + (size_t)sl * NT * 128 + 16 * (2 * u + (kg & 1)) + 8 * (kg >> 1) + 2 * v;
  const int blk = 8 * sl + 4 * (kg & 1) + (m >> 2);
  const unsigned char* HQl = ws + WS_HQ + (m & 1) * 512 + blk * 16; const unsigned char* HSl = ws + WS_HS + blk;
  const bool live = (kg >> 1) == ((m >> 1) & 1), diag = kg == v, b0 = (v & 1) != 0, b1 = (v & 2) != 0; const int sdec = 2 * (m & 1);
  int t = (x >> 2) * (NT / 2) + rank * NWAVES + wave;
  PeerIdx ia = peer_load_idx(IDX, t, q), ib = peer_load_idx(IDX, t + nslot, q);
  PeerRows ra = peer_gather(TD, ia, laneoff), rb;
  u32x4 ha, hb; unsigned sa, sb;
  { const int tc = t < te ? t : te - 1; ha = *(const u32x4*)(HQl + (size_t)tc * 1024); sa = HSl[(size_t)tc * 32]; }
#pragma unroll 1
  for (; t < te; t += 2 * nslot) {
    { const int tn = t + nslot, tc = tn < te ? tn : te - 1;
      rb = peer_gather(TD, ib, laneoff); hb = *(const u32x4*)(HQl + (size_t)tc * 1024); sb = HSl[(size_t)tc * 32];
      ia = peer_load_idx(IDX, t + 2 * nslot, q);
      PeerA A;
#pragma unroll
      for (int j = 0; j < 4; ++j) A.v[j] = live ? ha[j] : 0u;
      A.scale = (int)sa - sdec;
      peer_down_token(ra, A, PART + (size_t)t * 128, diag, b0, b1); }
    { const int tn = t + nslot; if (tn >= te) break;
      const int t2 = t + 2 * nslot, tc = t2 < te ? t2 : te - 1;
      ra = peer_gather(TD, ia, laneoff); ha = *(const u32x4*)(HQl + (size_t)tc * 1024); sa = HSl[(size_t)tc * 32];
      ib = peer_load_idx(IDX, t + 3 * nslot, q);
      PeerA A;
#pragma unroll
      for (int j = 0; j < 4; ++j) A.v[j] = live ? hb[j] : 0u;
      A.scale = (int)sb - sdec;
      peer_down_token(rb, A, PART + (size_t)tn * 128, diag, b0, b1); }
  }
}
__device__ __forceinline__ void peer_reduce_phase(const Params& p, int layer) {
  unsigned char* ws = p.ws;
  const int tid = opaque_tid();
  const bf16_t* PART = (const bf16_t*)(ws + WS_PART); const bf16_t* A1 = (const bf16_t*)(ws + WS_GW); const bf16_t* A2 = A1 + (size_t)NT * 128; bf16_t* CFo = (bf16_t*)(ws + WS_CF);
  constexpr int UB = 2;
  const size_t stride = (size_t)gridDim.x * NTHREADS, ngrp = (size_t)NT * 16;
#pragma unroll 1
  for (size_t i0 = (size_t)blockIdx.x * NTHREADS + tid; i0 < ngrp; i0 += UB * stride) {
    u32x4 pw[UB][4], a1[UB], a2[UB];
#pragma unroll
    for (int u = 0; u < UB; ++u) { const size_t i = min(i0 + u * stride, ngrp - 1);
#pragma unroll
      for (int x = 0; x < 4; ++x) pw[u][x] = *(const u32x4*)(PART + (size_t)x * NT * 128 + i * 8);
      a1[u] = *(const u32x4*)(A1 + i * 8); a2[u] = *(const u32x4*)(A2 + i * 8); }
#pragma unroll
    for (int u = 0; u < UB; ++u) { const size_t i = i0 + u * stride; if (i >= ngrp) break;
      float a[8];
#pragma unroll
      for (int j = 0; j < 8; ++j) a[j] = 0.f;
#pragma unroll
      for (int x = 0; x < 4; ++x)
#pragma unroll
        for (int j = 0; j < 4; ++j) { a[2 * j] += bf_lo(pw[u][x][j]); a[2 * j + 1] += bf_hi(pw[u][x][j]); }
      if (UP4_MFMA && ((UP4_MASK >> layer) & 1)) {
        f32x2 cf[4];
#pragma unroll
        for (int j = 0; j < 4; ++j) cf[j] = (f32x2){bf_lo(a2[u][j]) * gelu_tanh(a[2 * j] * bf_lo(a1[u][j])), bf_hi(a2[u][j]) * gelu_tanh(a[2 * j + 1] * bf_hi(a1[u][j]))};
        float am = 0.f;
#pragma unroll
        for (int j = 0; j < 4; ++j) am = fmaxf(am, fmaxf(fabsf(cf[j].x), fabsf(cf[j].y)));
        am = fmaxf(am, dppf<0xB1>(am)); am = fmaxf(am, dppf<0x4E>(am));
        const int s0 = max((int)(__float_as_uint(am) >> 23), 64) - 1;
        const float inv0 = __uint_as_float((unsigned)(254 - s0) << 23);
        unsigned w0 = 0u, w1 = 0u, w2 = 0u;
#define PEER_Q_BYTE(b) { const f32x2 fs = cf[b] * inv0; \
        w0 = __builtin_amdgcn_cvt_scalef32_pk_fp4_f32(w0, fs.x, fs.y, 1.0f, b); \
        const f32x2 r1 = (fs - __builtin_amdgcn_cvt_scalef32_pk_f32_fp4(w0, 1.0f, b)) * 4.0f; \
        w1 = __builtin_amdgcn_cvt_scalef32_pk_fp4_f32(w1, r1.x, r1.y, 1.0f, b); \
        const f32x2 r2 = (r1 - __builtin_amdgcn_cvt_scalef32_pk_f32_fp4(w1, 1.0f, b)) * 4.0f; \
        w2 = __builtin_amdgcn_cvt_scalef32_pk_fp4_f32(w2, r2.x, r2.y, 1.0f, b); }
        PEER_Q_BYTE(0) PEER_Q_BYTE(1) PEER_Q_BYTE(2) PEER_Q_BYTE(3)
#undef PEER_Q_BYTE
        unsigned char* rec = (unsigned char*)CFo + (i >> 4) * 256; const int G = (int)(i & 15);
        unsigned* q = (unsigned*)(rec + (G >> 2) * 16 + (G & 3) * 4);
        q[0] = w0; q[16] = w1; q[32] = w2;
        if ((G & 3) == 0) rec[192 + (G >> 2)] = (unsigned char)s0;
      } else {
        u32x4 w;
#pragma unroll
        for (int j = 0; j < 4; ++j) w[j] = pk2(bf_lo(a2[u][j]) * gelu_tanh(a[2 * j] * bf_lo(a1[u][j])), bf_hi(a2[u][j]) * gelu_tanh(a[2 * j + 1] * bf_hi(a1[u][j])));
        *(u32x4*)(CFo + i * 8) = w; } }
  }
}
struct PeerCoef { float v[16]; };
__device__ __forceinline__ PeerCoef peer_load_coef(const bf16_t* CF, int t, int r) {
  PeerCoef o; const int tt = t < NT ? t : NT - 1;
#pragma unroll
  for (int j = 0; j < 2; ++j) { const u32x4 g = *(const u32x4*)(CF + (size_t)tt * 128 + r * 16 + 8 * j);
#pragma unroll
    for (int k = 0; k < 4; ++k) { o.v[8 * j + 2 * k] = bf_lo(g[k]); o.v[8 * j + 2 * k + 1] = bf_hi(g[k]); } }
  return o;
}
__device__ __forceinline__ void peer_up_token(const PeerRows& R, const PeerCoef& cf, bf16_t* xr, unsigned xw, f32x2 gg, bool b5, bool b4, bool b3) {
  f32x2 acc[8];
#pragma unroll
  for (int j = 0; j < 8; ++j) acc[j] = (f32x2){0.f, 0.f};
#pragma unroll
  for (int i = 0; i < 16; ++i) { const f32x2 cc = (f32x2){cf.v[i], cf.v[i]};
#pragma unroll
    for (int j = 0; j < 4; ++j) { acc[2 * j] = __builtin_amdgcn_cvt_pk_f32_fp8((int)R.d[i][j], false) * cc + acc[2 * j]; acc[2 * j + 1] = __builtin_amdgcn_cvt_pk_f32_fp8((int)R.d[i][j], true) * cc + acc[2 * j + 1]; } }
  float a[16];
#pragma unroll
  for (int j = 0; j < 8; ++j) { a[2 * j] = acc[j].x; a[2 * j + 1] = acc[j].y; }
  float a1[8], a2[4], a3[2];
#pragma unroll
  for (int j = 0; j < 8; ++j) a1[j] = (b3 ? a[j + 8] : a[j]) + dppf<0x128>(b3 ? a[j] : a[j + 8]);
#pragma unroll
  for (int j = 0; j < 4; ++j) a2[j] = swap16_sum(a1[j], a1[j + 4]);
#pragma unroll
  for (int j = 0; j < 2; ++j) a3[j] = swap32_sum(a2[j], a2[j + 2]);
  *(unsigned*)xr = pk2(bf_lo(xw) + gg.x * a3[0], bf_hi(xw) + gg.y * a3[1]);
}
__device__ __forceinline__ void peer_up_phase(const Params& p, int layer) {
  unsigned char* ws = p.ws;
  const int tid = opaque_tid(), lane = tid & 63, wave = tid >> 6, r = lane >> 3, c = lane & 7;
  const int x = blockIdx.x & 7, rank = blockIdx.x >> 3, nslot = (gridDim.x >> 3) * NWAVES;
  if (rank >= (int)(gridDim.x >> 3)) return;
  const unsigned short* IDX = (const unsigned short*)(ws + WS_IDX); const bf16_t* CF = (const bf16_t*)(ws + WS_CF); const float* MOD = (const float*)(ws + WS_MOD);
  const unsigned char* TU = ws + WS_TU8 + (size_t)layer * NEXP * DM + (size_t)x * NEXP * 128; const unsigned laneoff = 16 * c;
  const int col = 128 * x + 16 * c + 8 * (r & 1) + 4 * ((r >> 1) & 1) + 2 * (r >> 2);
  bf16_t* XR = (bf16_t*)(ws + WS_XR) + col;
  const float* g2b = MOD + (size_t)(layer == 0 ? 0 : 3) * 6144 + 5 * DM + col;
  const bool b5 = (lane & 32) != 0, b4 = (lane & 16) != 0, b3 = (lane & 8) != 0;
  int t = rank * NWAVES + wave;
  PeerIdx ia = peer_load_idx(IDX, t, r), ib = peer_load_idx(IDX, t + nslot, r);
  PeerRows ra = peer_gather(TU, ia, laneoff), rb;
  PeerCoef ca = peer_load_coef(CF, t, r), cb;
  unsigned xa = *(const unsigned*)(XR + (size_t)min(t, NT - 1) * DM), xb; f32x2 ga = *(const f32x2*)(g2b + (size_t)(min(t, NT - 1) >> 14) * 6144), gb;
#pragma unroll 1
  for (; t < NT; t += 2 * nslot) {
    { const int tn = t + nslot, tc = min(tn, NT - 1);
      rb = peer_gather(TU, ib, laneoff); cb = peer_load_coef(CF, tn, r); xb = *(const unsigned*)(XR + (size_t)tc * DM); gb = *(const f32x2*)(g2b + (size_t)(tc >> 14) * 6144);
      ia = peer_load_idx(IDX, t + 2 * nslot, r);
      peer_up_token(ra, ca, XR + (size_t)t * DM, xa, ga, b5, b4, b3); }
    { const int tn = t + nslot; if (tn >= NT) break;
      const int tc = min(t + 2 * nslot, NT - 1);
      ra = peer_gather(TU, ia, laneoff); ca = peer_load_coef(CF, t + 2 * nslot, r); xa = *(const unsigned*)(XR + (size_t)tc * DM); ga = *(const f32x2*)(g2b + (size_t)(tc >> 14) * 6144);
      ib = peer_load_idx(IDX, t + 3 * nslot, r);
      peer_up_token(rb, cb, XR + (size_t)tn * DM, xb, gb, b5, b4, b3); }
  }
}
__device__ __forceinline__ void peer_up4_token(const PeerRows& R, const PeerCoef& cf, bf16_t* xr, u32x2 xw, f32x4 gg, bool b3) {
  f32x2 acc[16];
#pragma unroll
  for (int j = 0; j < 16; ++j) acc[j] = (f32x2){0.f, 0.f};
#pragma unroll
  for (int i = 0; i < 16; ++i) { const f32x2 cc = (f32x2){cf.v[i], cf.v[i]};
#pragma unroll
    for (int j = 0; j < 4; ++j) {
      acc[4 * j]     = __builtin_amdgcn_cvt_scalef32_pk_f32_fp4(R.d[i][j], 1.0f, 0) * cc + acc[4 * j];
      acc[4 * j + 1] = __builtin_amdgcn_cvt_scalef32_pk_f32_fp4(R.d[i][j], 1.0f, 1) * cc + acc[4 * j + 1];
      acc[4 * j + 2] = __builtin_amdgcn_cvt_scalef32_pk_f32_fp4(R.d[i][j], 1.0f, 2) * cc + acc[4 * j + 2];
      acc[4 * j + 3] = __builtin_amdgcn_cvt_scalef32_pk_f32_fp4(R.d[i][j], 1.0f, 3) * cc + acc[4 * j + 3]; } }
  float a[32];
#pragma unroll
  for (int j = 0; j < 16; ++j) { a[2 * j] = acc[j].x; a[2 * j + 1] = acc[j].y; }
  float a1[16], a2[8], a3[4];
#pragma unroll
  for (int j = 0; j < 16; ++j) a1[j] = (b3 ? a[j + 16] : a[j]) + dppf<0x128>(b3 ? a[j] : a[j + 16]);
#pragma unroll
  for (int j = 0; j < 8; ++j) a2[j] = swap16_sum(a1[j], a1[j + 8]);
#pragma unroll
  for (int j = 0; j < 4; ++j) a3[j] = swap32_sum(a2[j], a2[j + 4]);
  u32x2 w; w.x = pk2(bf_lo(xw.x) + gg[0] * a3[0], bf_hi(xw.x) + gg[1] * a3[1]); w.y = pk2(bf_lo(xw.y) + gg[2] * a3[2], bf_hi(xw.y) + gg[3] * a3[3]);
  *(u32x2*)xr = w;
}
__device__ __forceinline__ void peer_up4_phase(const Params& p, int layer) {
  unsigned char* ws = p.ws;
  const int tid = opaque_tid(), lane = tid & 63, wave = tid >> 6, r = lane >> 3, c = lane & 7;
  const int x = blockIdx.x & 7, rank = blockIdx.x >> 3, nslot = (gridDim.x >> 3) * NWAVES;
  if (rank >= (int)(gridDim.x >> 3)) return;
  const int sl = x & 3, te = ((x >> 2) + 1) * (NT / 2);
  const unsigned short* IDX = (const unsigned short*)(ws + WS_IDX); const bf16_t* CF = (const bf16_t*)(ws + WS_CF); const float* MOD = (const float*)(ws + WS_MOD);
  const unsigned char* TU = ws + WS_TU8 + (size_t)layer * NEXP * DM + (size_t)sl * NEXP * 128; const unsigned laneoff = 16 * c;
  const int col = 256 * sl + 32 * c + 16 * (r & 1) + 8 * ((r >> 1) & 1) + 4 * (r >> 2);
  bf16_t* XR = (bf16_t*)(ws + WS_XR) + col;
  const float* g2b = MOD + (size_t)(layer == 0 ? 0 : 3) * 6144 + 5 * DM + col;
  const bool b3 = (lane & 8) != 0;
  int t = (x >> 2) * (NT / 2) + rank * NWAVES + wave;
  PeerIdx ia = peer_load_idx(IDX, t, r), ib = peer_load_idx(IDX, t + nslot, r);
  PeerRows ra = peer_gather(TU, ia, laneoff), rb;
  PeerCoef ca = peer_load_coef(CF, t, r), cb;
  u32x2 xa = *(const u32x2*)(XR + (size_t)min(t, te - 1) * DM), xb; f32x4 ga = *(const f32x4*)(g2b + (size_t)(min(t, te - 1) >> 14) * 6144), gb;
#pragma unroll 1
  for (; t < te; t += 2 * nslot) {
    { const int tn = t + nslot, tc = min(tn, te - 1);
      rb = peer_gather(TU, ib, laneoff); cb = peer_load_coef(CF, tn, r); xb = *(const u32x2*)(XR + (size_t)tc * DM); gb = *(const f32x4*)(g2b + (size_t)(tc >> 14) * 6144);
      ia = peer_load_idx(IDX, t + 2 * nslot, r);
      peer_up4_token(ra, ca, XR + (size_t)t * DM, xa, ga, b3); }
    { const int tn = t + nslot; if (tn >= te) break;
      const int tc = min(t + 2 * nslot, te - 1);
      ra = peer_gather(TU, ia, laneoff); ca = peer_load_coef(CF, t + 2 * nslot, r); xa = *(const u32x2*)(XR + (size_t)tc * DM); ga = *(const f32x4*)(g2b + (size_t)(tc >> 14) * 6144);
      ib = peer_load_idx(IDX, t + 3 * nslot, r);
      peer_up4_token(rb, cb, XR + (size_t)tn * DM, xb, gb, b3); }
  }
}
typedef unsigned short u16x2 __attribute__((ext_vector_type(2)));
__device__ __forceinline__ int bf16_block_exp(const u32x4 h0, const u32x4 h1, const u32x4 h2, const u32x4 h3) {
  u16x2 mx = (u16x2){0, 0};
#pragma unroll
  for (int j = 0; j < 4; ++j) {
    mx = __builtin_elementwise_max(mx, __builtin_bit_cast(u16x2, h0[j] & 0x7fff7fffu)); mx = __builtin_elementwise_max(mx, __builtin_bit_cast(u16x2, h1[j] & 0x7fff7fffu));
    mx = __builtin_elementwise_max(mx, __builtin_bit_cast(u16x2, h2[j] & 0x7fff7fffu)); mx = __builtin_elementwise_max(mx, __builtin_bit_cast(u16x2, h3[j] & 0x7fff7fffu)); }
  const unsigned m = __builtin_bit_cast(unsigned, mx);
  return (int)(max(m & 0xffffu, m >> 16) >> 7);
}
__device__ __forceinline__ PeerA peer_build_a3(const u32x4 h0, const u32x4 h1, const u32x4 h2, const u32x4 h3, int st, bool live) {
  const int s0 = max(bf16_block_exp(h0, h1, h2, h3), 64) - 1;
  const float inv0 = __builtin_bit_cast(float, (unsigned)(254 - s0) << 23);
  PeerA o;
#pragma unroll
  for (int j = 0; j < 4; ++j) { unsigned w0 = 0u, w1 = 0u, w2 = 0u; const u32x4& hq = j == 0 ? h0 : j == 1 ? h1 : j == 2 ? h2 : h3;
#define PEER_A_BYTE(b) { const f32x2 fs = (f32x2){bf_lo(hq[b]), bf_hi(hq[b])} * inv0; \
      w0 = __builtin_amdgcn_cvt_scalef32_pk_fp4_f32(w0, fs.x, fs.y, 1.0f, b); \
      const f32x2 r1 = (fs - __builtin_amdgcn_cvt_scalef32_pk_f32_fp4(w0, 1.0f, b)) * 4.0f; \
      w1 = __builtin_amdgcn_cvt_scalef32_pk_fp4_f32(w1, r1.x, r1.y, 1.0f, b); \
      const f32x2 r2 = (r1 - __builtin_amdgcn_cvt_scalef32_pk_f32_fp4(w1, 1.0f, b)) * 4.0f; \
      w2 = __builtin_amdgcn_cvt_scalef32_pk_fp4_f32(w2, r2.x, r2.y, 1.0f, b); }
    PEER_A_BYTE(0) PEER_A_BYTE(1) PEER_A_BYTE(2) PEER_A_BYTE(3)
#undef PEER_A_BYTE
    o.v[j] = live ? (st == 0 ? w0 : st == 1 ? w1 : w2) : 0u; }
  o.scale = s0 - 2 * st;
  return o;
}
typedef int i32x2 __attribute__((ext_vector_type(2)));
__device__ __forceinline__ void peer_up4m_stage(const PeerRows& R, LAS unsigned char* wl, unsigned W0) {
  asm volatile("" : "+v"(W0));
#pragma unroll
  for (int g = 0; g < 16; ++g) {
    const unsigned k = 16u * ((g >> 1) & 7) + 128u * g;
    *(LAS u32x2*)(wl + (W0 ^ k)) = (u32x2){R.d[g][0], R.d[g][1]};
    *(LAS u32x2*)(wl + (W0 ^ (k + 8u))) = (u32x2){R.d[g][2], R.d[g][3]}; }
}
__device__ __forceinline__ void peer_up4m_token(const PeerA A, LAS unsigned char* wl, unsigned R0, int lane, bf16_t* xr, u32x2 xw, f32x4 gg) {
  asm volatile("" : "+v"(R0));
  const f32x4 z = (f32x4){0.f, 0.f, 0.f, 0.f};
  const i32x8 a = (i32x8){(int)A.v[0], (int)A.v[1], (int)A.v[2], (int)A.v[3], 0, 0, 0, 0};
  float o16[16];
#pragma unroll
  for (int T = 0; T < 16; ++T) {
    const i32x2 b0 = __builtin_amdgcn_ds_read_tr4_b64_v2i32((LAS i32x2*)(wl + (R0 ^ (8u * T)))), b1 = __builtin_amdgcn_ds_read_tr4_b64_v2i32((LAS i32x2*)(wl + ((R0 ^ 128u ^ (8u * T)) + 2048)));
    const i32x8 b = (i32x8){b0[0], b0[1], b1[0], b1[1], 0, 0, 0, 0};
    const f32x4 d = __builtin_amdgcn_mfma_scale_f32_16x16x128_f8f6f4(a, b, z, 4, 4, 0, A.scale, 0, 0x7f7f7f7f);
    o16[T] = (d[0] + d[1]) + d[2];
    if ((T & 1) == 1) __builtin_amdgcn_sched_barrier(0); }
#pragma unroll
  for (int T = 0; T < 16; ++T) *(LAS float*)(wl + T * 256 + lane * 4) = o16[T];
  const f32x4 v = *(const LAS f32x4*)(wl + (lane >> 2) * 256 + (lane & 3) * 16);
  u32x2 w; w.x = pk2(bf_lo(xw.x) + gg[0] * v[0], bf_hi(xw.x) + gg[1] * v[1]); w.y = pk2(bf_lo(xw.y) + gg[2] * v[2], bf_hi(xw.y) + gg[3] * v[3]);
  *(u32x2*)xr = w;
}
struct PeerARaw { u32x4 v; unsigned sc; };
__device__ __forceinline__ PeerARaw peer_load_a(const unsigned char* CFQ, int t, int aoff) { PeerARaw o; const unsigned char* rec = CFQ + (size_t)t * 256; o.v = *(const u32x4*)(rec + aoff); o.sc = *(const unsigned*)(rec + 192); return o; }
__device__ __forceinline__ PeerA peer_make_a(const PeerARaw& q, int st, int kg, bool live) {
  PeerA o;
#pragma unroll
  for (int j = 0; j < 4; ++j) o.v[j] = live ? q.v[j] : 0u;
  o.scale = (int)((q.sc >> (8 * kg)) & 255u) - 2 * st;
  return o;
}
__device__ __forceinline__ void peer_up4m_phase(const Params& p, LAS unsigned char* lds, int layer) {
  unsigned char* ws = p.ws;
  const int tid = opaque_tid(), lane = tid & 63, wave = tid >> 6, r = lane >> 3, c = lane & 7, n = lane & 15, kg = lane >> 4;
  const int x = blockIdx.x & 7, rank = blockIdx.x >> 3, nslot = (gridDim.x >> 3) * NWAVES;
  if (rank >= (int)(gridDim.x >> 3)) return;
  const int sl = x & 3, te = ((x >> 2) + 1) * (NT / 2);
  LAS unsigned char* wl = lds + wave * 16384;
  const unsigned W0 = (unsigned)(16 * r * 128 + 128 * (r & 1) + 16 * c + 8 * ((r >> 1) & 1));
  const unsigned R0 = (unsigned)((32 * kg + n) * 128 + 16 * ((n >> 1) & 7) + 8 * (kg & 1));
  const unsigned short* IDX = (const unsigned short*)(ws + WS_IDX); const unsigned char* CFQ = ws + WS_CF; const float* MOD = (const float*)(ws + WS_MOD);
  const unsigned char* TU = ws + WS_TU8 + (size_t)layer * NEXP * DM + (size_t)sl * NEXP * 128; const unsigned laneoff = 16 * c;
  const int col = 256 * sl + 4 * lane;
  bf16_t* XR = (bf16_t*)(ws + WS_XR) + col;
  const float* g2b = MOD + (size_t)(layer == 0 ? 0 : 3) * 6144 + 5 * DM + col;
  const int st = lane & 15; const bool live = st < 3; const int aoff = ((live ? st : 0) * 4 + kg) * 16;
  int t = (x >> 2) * (NT / 2) + rank * NWAVES + wave;
  PeerIdx ia = peer_load_idx(IDX, t, r), ib = peer_load_idx(IDX, t + nslot, r);
  PeerRows ra = peer_gather(TU, ia, laneoff), rb = peer_gather(TU, ib, laneoff);
  ia = peer_load_idx(IDX, t + 2 * nslot, r); ib = peer_load_idx(IDX, t + 3 * nslot, r);
  PeerARaw qa = peer_load_a(CFQ, min(t, te - 1), aoff), qb;
  u32x2 xa = *(const u32x2*)(XR + (size_t)min(t, te - 1) * DM), xb;
  const f32x4 gg = *(const f32x4*)(g2b + (size_t)(x >> 2) * 6144);
  __syncthreads();
#pragma unroll 1
  for (; t < te; t += 2 * nslot) {
    { const int tc = min(t + nslot, te - 1);
      peer_up4m_stage(ra, wl, W0); __builtin_amdgcn_sched_barrier(0);
      ra = peer_gather(TU, ia, laneoff); ia = peer_load_idx(IDX, t + 4 * nslot, r); __builtin_amdgcn_sched_barrier(0);
      qb = peer_load_a(CFQ, tc, aoff); xb = *(const u32x2*)(XR + (size_t)tc * DM);
      peer_up4m_token(peer_make_a(qa, st, kg, live), wl, R0, lane, XR + (size_t)t * DM, xa, gg); }
    { const int tn = t + nslot; if (tn >= te) break;
      const int tc = min(t + 2 * nslot, te - 1);
      peer_up4m_stage(rb, wl, W0); __builtin_amdgcn_sched_barrier(0);
      rb = peer_gather(TU, ib, laneoff); ib = peer_load_idx(IDX, t + 5 * nslot, r); __builtin_amdgcn_sched_barrier(0);
      qa = peer_load_a(CFQ, tc, aoff); xa = *(const u32x2*)(XR + (size_t)tc * DM);
      peer_up4m_token(peer_make_a(qb, st, kg, live), wl, R0, lane, XR + (size_t)tn * DM, xb, gg); }
  }
}
__device__ __forceinline__ void final_norm_phase(const Params& p) {
  const int tid = opaque_tid(), lane = tid & 63, wave = tid >> 6;
  const int gw = blockIdx.x * NWAVES + wave, NGW = gridDim.x * NWAVES;
  constexpr int RB = 4;
  f32x4 FG[4];
#pragma unroll
  for (int j = 0; j < 4; ++j) FG[j] = ((const f32x4*)p.final_g)[lane + 64 * j];
#pragma unroll 1
  for (int r0 = gw; r0 < NT; r0 += RB * NGW) {
    f32x4 v[RB][4];
#pragma unroll
    for (int q = 0; q < RB; ++q) { const int r = min(r0 + q * NGW, NT - 1); const u32x2* xr = (const u32x2*)((const bf16_t*)(p.ws + WS_XR) + (size_t)r * DM) + lane;
#pragma unroll
      for (int j = 0; j < 4; ++j) { const u32x2 w = xr[64 * j]; v[q][j] = (f32x4){bf_lo(w.x), bf_hi(w.x), bf_lo(w.y), bf_hi(w.y)}; } }
#pragma unroll
    for (int q = 0; q < RB; ++q) { const int r = r0 + q * NGW; if (r >= NT) break;
      float ss = 0.f;
#pragma unroll
      for (int j = 0; j < 4; ++j) ss += (v[q][j][0] * v[q][j][0] + v[q][j][1] * v[q][j][1]) + (v[q][j][2] * v[q][j][2] + v[q][j][3] * v[q][j][3]);
      const float rr = rsqrtf(wave_sum(ss) * (1.0f / DM) + 1e-6f);
      f32x4* xo = (f32x4*)(p.out + (size_t)r * DM) + lane;
#pragma unroll
      for (int j = 0; j < 4; ++j) __builtin_nontemporal_store(v[q][j] * rr * FG[j], xo + 64 * j);
    }
  }
}

__device__ __forceinline__ void pool_fused_phase(const Params& p, LAS unsigned char* lds) {
  unsigned char* ws = p.ws;
  const int tid = opaque_tid(), lane = tid & 63, wave = tid >> 6;
  const float* MOD = (const float*)(ws + WS_MOD); bf16_t* PO = (bf16_t*)(ws + WS_CAT);
  const float* ng = p.norm1_g + DM;
  u32x2 pre[6][4];
  auto fetch_rows = [&](int tile) {
    const int t0 = tile * 32, s0 = t0 & (SEQL - 1), b = t0 >> 14;
#pragma unroll
    for (int q = 0; q < 6; ++q) { const int pos = min(max(s0 - 8 + wave + q * NWAVES, 0), SEQL - 1); const u32x2* xr = (const u32x2*)((const bf16_t*)(ws + WS_XR) + (size_t)(b * SEQL + pos) * DM) + lane;
#pragma unroll
      for (int e = 0; e < 4; ++e) pre[q][e] = xr[64 * e]; }
  };
  if (xcd_item(0, NT / 32) < NT / 32) fetch_rows(xcd_item(0, NT / 32));
#pragma unroll 1
  for (int rnd = 0, tile = xcd_item(0, NT / 32); tile < NT / 32; tile = xcd_item(++rnd, NT / 32)) {
    const int t0 = tile * 32, s0 = t0 & (SEQL - 1), b = t0 >> 14;
    const float* sh = MOD + (size_t)(3 + b) * 6144; const float* sc = sh + DM;
    f32x4 PA[4], PB[4];
#pragma unroll
    for (int e = 0; e < 4; ++e) { PA[e] = ((const f32x4*)ng)[lane + 64 * e] * (((const f32x4*)sc)[lane + 64 * e] + 1.0f); PB[e] = ((const f32x4*)sh)[lane + 64 * e]; }
    __syncthreads();
#pragma unroll
    for (int q = 0; q < 6; ++q) { const int j = wave + q * NWAVES, pos = s0 - 8 + j;
      if (pos >= 0 && pos < SEQL) {
        f32x4 v[4]; float ss = 0.f;
#pragma unroll
        for (int e = 0; e < 4; ++e) { const u32x2 w = pre[q][e]; v[e] = (f32x4){bf_lo(w.x), bf_hi(w.x), bf_lo(w.y), bf_hi(w.y)}; ss += (v[e][0] * v[e][0] + v[e][1] * v[e][1]) + (v[e][2] * v[e][2] + v[e][3] * v[e][3]); }
        const float r = rsqrtf(wave_sum(ss) * (1.0f / DM) + 1e-6f);
        LAS u32x2* o8 = (LAS u32x2*)(lds + j * 2048) + lane;
#pragma unroll
        for (int e = 0; e < 4; ++e) { const f32x4 y = (v[e] * r) * PA[e] + PB[e]; u32x2 w; w.x = pk2(y[0], y[1]); w.y = pk2(y[2], y[3]); o8[64 * e] = w; }
      }
    }
    __syncthreads();
    if (xcd_item(rnd + 1, NT / 32) < NT / 32) fetch_rows(xcd_item(rnd + 1, NT / 32));
    { const int grp = wave & 3, ch = grp * 32 + (lane & 31);
      auto pool_tok = [&](auto HWc, int tok) {
        constexpr int HW = decltype(HWc)::value;
        const int sq = s0 + tok;
        u32x4 w[2 * HW];
#pragma unroll
        for (int q = 0; q < 2 * HW; ++q) w[q] = *(const LAS u32x4*)(lds + (tok + 8 - HW + q) * 2048 + ch * 16);
        const u32x4 c = *(const LAS u32x4*)(lds + (tok + 8) * 2048 + ch * 16);
        float sum[8]; float cnt = 0.f;
#pragma unroll
        for (int j = 0; j < 8; ++j) sum[j] = 0.f;
#pragma unroll
        for (int q = 0; q < 2 * HW; ++q) { const int pos = sq - HW + q; const bool ok = (pos >= 0 && pos < SEQL); cnt += ok ? 1.0f : 0.0f;
#pragma unroll
          for (int j = 0; j < 4; ++j) { sum[2 * j] += ok ? bf_lo(w[q][j]) : 0.0f; sum[2 * j + 1] += ok ? bf_hi(w[q][j]) : 0.0f; } }
        const float inv = 1.0f / cnt; u32x4 o;
#pragma unroll
        for (int j = 0; j < 4; ++j) o[j] = pk2(sum[2 * j] * inv - bf_lo(c[j]), sum[2 * j + 1] * inv - bf_hi(c[j]));
        *(u32x4*)(PO + (size_t)(t0 + tok) * DM + ch * 8) = o;
      };
#pragma unroll 1
      for (int i = 0; i < 8; ++i) {
        const int tok = (wave >> 2) * 16 + 2 * i + (lane >> 5);
        if (grp == 0) pool_tok(std::integral_constant<int, 1>{}, tok);
        else if (grp == 1) pool_tok(std::integral_constant<int, 2>{}, tok);
        else if (grp == 2) pool_tok(std::integral_constant<int, 4>{}, tok);
        else pool_tok(std::integral_constant<int, 8>{}, tok);
      }
    }
  }
  __syncthreads();
}

typedef const __attribute__((address_space(4))) Params* ParamsK;
__device__ __forceinline__ Params load_params() {
#if defined(__HIP_DEVICE_COMPILE__)
  ParamsK k = (ParamsK)__builtin_amdgcn_kernarg_segment_ptr(); asm volatile("" : "+s"(k)); return *k;
#else
  return Params{};
#endif
}
#define XBAR() do { XcdBarrier xb_; xb_.bar = (unsigned*)(load_params().ws + WS_BAR); xb_.x = xb_xcc_id(); xb_.st = (volatile LAS unsigned*)(lds + 131072); xcd_barrier(xb_); } while (0)

__global__ void __launch_bounds__(NTHREADS, 2) fwd_megakernel(Params p_arg) {
  extern __shared__ __attribute__((aligned(16))) unsigned char lds_raw[];
  LAS unsigned char* lds = (LAS unsigned char*)lds_raw;
  cg::grid_group grid = cg::this_grid();
  { volatile LAS unsigned* bst = (volatile LAS unsigned*)(lds + 131072);
    if (threadIdx.x < 4) bst[threadIdx.x] = 0u;
    if ((threadIdx.x & 63) == 0) *(volatile LAS unsigned*)(size_t)(LDS_WAVETAB + 4 * __builtin_amdgcn_s_getreg((5 << 11) | 4)) = threadIdx.x >> 6;
    __syncthreads();
    (void)xcd_barrier_post((unsigned*)(load_params().ws + WS_BAR), bst); }

  { const Params p = load_params(); phase_prep(p, lds); }
  if (p_arg.out == nullptr) grid.sync();
  XBAR();
  { const Params p = load_params(); unsigned char* ws = p.ws; const float* MOD = (const float*)(ws + WS_MOD); bf16_t* H = (bf16_t*)(ws + WS_H);
    const int tid = opaque_tid(), lane = tid & 63, wave = tid >> 6, gw = blockIdx.x * NWAVES + wave, NGW = gridDim.x * NWAVES;
    constexpr int RB = 4;
#pragma unroll 1
    for (int cls = 0; cls < 3; ++cls) {
      const int rbeg = cls == 0 ? 0 : (cls == 1 ? SEQL : NT), rend = cls == 0 ? SEQL : (cls == 1 ? NT : NTALL);
      const float* m = MOD + (size_t)cls * 6144;
      f32x4 A[4], B[4];
#pragma unroll
      for (int j = 0; j < 4; ++j) { A[j] = ((const f32x4*)p.norm1_g)[lane + 64 * j] * (((const f32x4*)(m + DM))[lane + 64 * j] + 1.0f); B[j] = ((const f32x4*)m)[lane + 64 * j]; }
#pragma unroll 1
      for (int r0 = rbeg + gw; r0 < rend; r0 += RB * NGW) {
        f32x4 v[RB][4];
#pragma unroll
        for (int q = 0; q < RB; ++q) { const int r = min(r0 + q * NGW, rend - 1); const f32x4* xr = (const f32x4*)(r < NT ? p.x + (size_t)r * DM : p.ctx + (size_t)(r - NT) * DM) + lane;
#pragma unroll
          for (int j = 0; j < 4; ++j) v[q][j] = xr[64 * j]; }
#pragma unroll
        for (int q = 0; q < RB; ++q) { const int r = r0 + q * NGW; if (r >= rend) break;
          float ss = 0.f;
#pragma unroll
          for (int j = 0; j < 4; ++j) ss += (v[q][j][0] * v[q][j][0] + v[q][j][1] * v[q][j][1]) + (v[q][j][2] * v[q][j][2] + v[q][j][3] * v[q][j][3]);
          const float rr = rsqrtf(wave_sum(ss) * (1.0f / DM) + 1e-6f);
          u32x2* o8 = (u32x2*)(H + (size_t)r * DM) + lane;
#pragma unroll
          for (int j = 0; j < 4; ++j) { const f32x4 y = (v[q][j] * rr) * A[j] + B[j]; u32x2 w; w.x = pk2(y[0], y[1]); w.y = pk2(y[2], y[3]); o8[64 * j] = w; }
        }
      }
    } }
  XBAR();
  { const Params p = load_params(); unsigned char* ws = p.ws;
    pg8::Gemm g{(const bf16_t*)(ws + WS_H), (const bf16_t*)(ws + WS_WIN), DM, DM, 0}; pg8::OrderG1 S; S.so.init(NT, INW, gridDim.x, blockIdx.x);
    EpiG1 E{(bf16_t*)(ws + WS_QB), (bf16_t*)(ws + WS_KB), (bf16_t*)(ws + WS_VT), (bf16_t*)(ws + WS_KC), (bf16_t*)(ws + WS_VCT), (bf16_t*)(ws + WS_UB), (bf16_t*)(ws + WS_GT), (const float*)(ws + WS_ROPE)};
    pg8::gemm_phase(lds, g, S, E);
    { const int G = gridDim.x, nunits = 898, maxu = (nunits + G - 1) / G, nfull = nunits - (maxu - 1) * G;
      const int nslack = (nfull == G) ? 0 : G - nfull; const int tid2 = opaque_tid();
      if (nslack == 0) convert_tables(p, 1, blockIdx.x * NWAVES + (tid2 >> 6), G * NWAVES, tid2 & 63);
      else if ((int)blockIdx.x >= nfull) convert_tables(p, 1, ((int)blockIdx.x - nfull) * NWAVES + (tid2 >> 6), nslack * NWAVES, tid2 & 63); } }
  XBAR();
  { const Params p = load_params(); attn_phase(p, lds); }
  { const Params p = load_params(); gmlp_phase(p, lds); }
  XBAR();
  { const Params p = load_params(); unsigned char* ws = p.ws;
    pg8::Gemm g{(const bf16_t*)(ws + WS_CAT), (const bf16_t*)(ws + WS_WOUT), DM, DM, 0}; pg8::StaticOrder S; S.init(NT, DM, gridDim.x, blockIdx.x);
    EpiBf16 E{(bf16_t*)(ws + WS_Y), DM};
    pg8::gemm_phase(lds, g, S, E); }
  XBAR();
#pragma unroll 1
  for (int layer = 0; layer < 2; ++layer) {
    { const Params p = load_params(); resid_norm_phase(p, layer); }
    XBAR();
    { const Params p = load_params(); unsigned char* ws = p.ws;
      pg8::Gemm g{(const bf16_t*)(ws + WS_H), (const bf16_t*)(ws + WS_WQ) + (size_t)layer * 2048 * DM, DM, DM, 0}; pg8::StaticOrder S; S.init(NT, 2048, gridDim.x, blockIdx.x);
      EpiF16 E{(unsigned short*)(ws + WS_QP), 2048};
      pg8::gemm_phase(lds, g, S, E); }
    XBAR();
    { const Params p = load_params(); topk_phase(p, lds, layer); }
    XBAR();
    { const Params p = load_params(); peer_down_phase(p, layer); }
    XBAR();
    { const Params p = load_params(); peer_reduce_phase(p, layer); }
    XBAR();
    { const Params p = load_params(); if ((UP4_MASK >> layer) & 1) { if (UP4_MFMA) peer_up4m_phase(p, lds, layer); else peer_up4_phase(p, layer); } else peer_up_phase(p, layer); }
    XBAR();
    if (layer == 0) {
      { const Params p = load_params(); pool_fused_phase(p, lds); }
      XBAR();
      { const Params p = load_params(); unsigned char* ws = p.ws;
        pg8::Gemm g{(const bf16_t*)(ws + WS_CAT), (const bf16_t*)(ws + WS_WPOOL), DM, 256, 256}; pg8::StaticOrder S; S.init(NT, DM, gridDim.x, blockIdx.x);
        EpiBf16 E{(bf16_t*)(ws + WS_Y), DM};
        pg8::gemm_phase(lds, g, S, E); }
      XBAR();
    } else {
      { const Params p = load_params(); final_norm_phase(p); }
    }
  }
}

extern "C" void kernel_launch(void* const* d_in, const int* in_sizes, int n_in, void* d_out, int out_size, void* d_ws, size_t ws_size, hipStream_t stream) {
  static int grid_blocks = 0;
  if (grid_blocks == 0) {
    if (n_in != 20 || ws_size < WS_END || out_size != NT * DM) { fprintf(stderr, "kernel_launch: unexpected shapes (n_in %d, ws %zu < %zu, out %d)\n", n_in, ws_size, (size_t)WS_END, out_size); grid_blocks = -1; return; }
    int dev = 0, cus = 0, per_cu = 0;
    (void)hipGetDevice(&dev);
    (void)hipDeviceGetAttribute(&cus, hipDeviceAttributeMultiprocessorCount, dev);
    if (hipFuncSetAttribute((const void*)fwd_megakernel, hipFuncAttributeMaxDynamicSharedMemorySize, LDS_BYTES) != hipSuccess) { fprintf(stderr, "kernel_launch: hipFuncSetAttribute failed\n"); grid_blocks = -1; return; }
    if (hipOccupancyMaxActiveBlocksPerMultiprocessor(&per_cu, (const void*)fwd_megakernel, NTHREADS, LDS_BYTES) != hipSuccess || per_cu < 1) { fprintf(stderr, "kernel_launch: occupancy query says %d blocks per CU\n", per_cu); grid_blocks = -1; return; }
    grid_blocks = cus;
  }
  if (grid_blocks < 0) return;
  Params p{};
  p.x = (const float*)d_in[0]; p.c = (const float*)d_in[1]; p.ctx = (const float*)d_in[2]; p.c_ctx = (const float*)d_in[3]; p.mod_w = (const float*)d_in[4]; p.mod_b = (const float*)d_in[5];
  p.norm1_g = (const float*)d_in[6]; p.norm2_g = (const float*)d_in[7]; p.attn_in_w = (const float*)d_in[8]; p.attn_out_w = (const float*)d_in[9]; p.attn_sink = (const float*)d_in[10];
  p.gmlp_w_s = (const float*)d_in[11]; p.gmlp_b_s = (const float*)d_in[12]; p.pool_w = (const float*)d_in[13]; p.pool_scale = (const float*)d_in[14]; p.peer_w_q = (const float*)d_in[15];
  p.peer_sub_keys = (const float*)d_in[16]; p.peer_down = (const float*)d_in[17]; p.peer_up = (const float*)d_in[18]; p.final_g = (const float*)d_in[19];
  p.out = (float*)d_out; p.ws = (unsigned char*)d_ws;
  (void)hipMemsetAsync((char*)d_ws + WS_BAR, 0, XCD_BAR_WORDS * 4, stream);
  void* args[] = {&p};
  hipError_t e = hipLaunchCooperativeKernel((void*)fwd_megakernel, dim3(grid_blocks), dim3(NTHREADS), args, LDS_BYTES, stream);
  if (e != hipSuccess) fprintf(stderr, "cooperative launch failed: %s (grid %d)\n", hipGetErrorString(e), grid_blocks);
}
```

```cpp
#include <hip/hip_runtime.h>
#include <hip/hip_cooperative_groups.h>
#include <cstdio>
#include <type_traits>
namespace cg = cooperative_groups;

#define LAS __attribute__((address_space(3)))
typedef unsigned short bf16_t;
typedef short bf16x8 __attribute__((ext_vector_type(8)));
typedef __bf16 bf16v2 __attribute__((ext_vector_type(2)));
typedef float f32x4 __attribute__((ext_vector_type(4)));
typedef float f32x2 __attribute__((ext_vector_type(2)));
typedef unsigned u32x4 __attribute__((ext_vector_type(4)));
typedef unsigned u32x2 __attribute__((ext_vector_type(2)));

constexpr int DM = 1024, NB = 2, SEQL = 16384, NT = NB * SEQL, CTXL = 256, NTC = NB * CTXL, NTALL = NT + NTC;
constexpr int INW = 1792, NEXP = 16384;
constexpr int NTHREADS = 512, NWAVES = 8;
constexpr int LDS_BYTES = 135168;

constexpr size_t WS_BAR   = 0;
constexpr size_t WS_MOD   = 16384;
constexpr size_t WS_ROPE  = WS_MOD + 131072;
constexpr size_t WS_WIN   = WS_ROPE + 32768;
constexpr size_t WS_WOUT  = WS_WIN + (size_t)INW * DM * 2;
constexpr size_t WS_WQ    = WS_WOUT + (size_t)DM * DM * 2;
constexpr size_t WS_WPOOL = WS_WQ + (size_t)2 * 2048 * DM * 2;
constexpr size_t WS_SK    = WS_WPOOL + (size_t)1024 * 256 * 2;
constexpr size_t WS_WS    = WS_SK + (size_t)2 * 2 * 128 * 128 * 2;
constexpr size_t WS_TD4   = WS_WS + (size_t)8 * 128 * 128 * 2;
constexpr size_t WS_TU4   = WS_TD4 + (size_t)2 * NEXP * 512;
constexpr size_t WS_SD    = WS_TU4 + (size_t)2 * NEXP * 512;
constexpr size_t WS_SU    = WS_SD + (size_t)2 * NEXP * 4;
constexpr size_t WS_H     = WS_SU + (size_t)2 * NEXP * 4;
constexpr size_t WS_R1    = WS_H + (size_t)NTALL * DM * 2;
constexpr size_t WS_CAT   = WS_R1;
constexpr size_t WS_QB    = WS_CAT + (size_t)NT * DM * 2;
constexpr size_t WS_KB    = WS_QB + (size_t)NT * 512 * 2;
constexpr size_t WS_VT    = WS_KB + (size_t)NT * 128 * 2;
constexpr size_t WS_KC    = WS_VT + (size_t)NT * 128 * 2;
constexpr size_t WS_VCT   = WS_KC + (size_t)NTC * 128 * 2;
constexpr size_t WS_UB    = WS_VCT + (size_t)NTC * 128 * 2;
constexpr size_t WS_GT    = WS_UB + (size_t)NT * 512 * 2;
constexpr size_t WS_Y     = WS_QB;
constexpr size_t WS_QP    = WS_QB;
constexpr size_t WS_R1END = WS_QP + (size_t)NT * 2048 * 2;
constexpr size_t WS_IDX   = WS_R1END;
constexpr size_t WS_GW    = WS_IDX + (size_t)NT * 128 * 4;
constexpr size_t WS_PART  = WS_QP;
constexpr size_t WS_CF    = WS_GW + (size_t)NT * 128 * 4;
constexpr size_t WS_XR    = WS_CF + (size_t)NT * 128 * 4;
constexpr size_t WS_HQ    = WS_XR + (size_t)NT * DM * 2;
constexpr size_t WS_HS    = WS_HQ + (size_t)NT * 1024;
constexpr size_t WS_END   = WS_HS + (size_t)NT * 32;
static_assert(WS_GT + (size_t)NT * 512 * 2 <= WS_R1END, "layout");
static_assert(NT / 2 == SEQL, "the PEER passes split the tokens in two halves and take one half = one batch");

struct Params {
  const float *x, *c, *ctx, *c_ctx, *mod_w, *mod_b, *norm1_g, *norm2_g, *attn_in_w, *attn_out_w, *attn_sink, *gmlp_w_s, *gmlp_b_s,
      *pool_w, *pool_scale, *peer_w_q, *peer_sub_keys, *peer_down, *peer_up, *final_g;
  float* out; unsigned char* ws;
};

__device__ __forceinline__ unsigned pk2(float lo, float hi) { unsigned r; asm volatile("v_cvt_pk_bf16_f32 %0, %1, %2" : "=v"(r) : "v"(lo), "v"(hi)); return r; }
__device__ __forceinline__ float bf_lo(unsigned w) { return __uint_as_float(w << 16); }
__device__ __forceinline__ float bf_hi(unsigned w) { return __uint_as_float(w & 0xffff0000u); }
template <int CTRL> __device__ __forceinline__ float dppf(float v) { return __builtin_bit_cast(float, __builtin_amdgcn_update_dpp(0, __builtin_bit_cast(int, v), CTRL, 0xf, 0xf, true)); }
constexpr unsigned LDS_WAVETAB = 131072 + 256;
__device__ __forceinline__ int opaque_tid() {
  const unsigned hw = __builtin_amdgcn_s_getreg((5 << 11) | 4);
  const unsigned w = *(volatile LAS unsigned*)(size_t)(LDS_WAVETAB + 4 * hw);
  unsigned z = 0u; asm volatile("" : "+v"(z));
  int t = (int)((w << 6) | __builtin_amdgcn_mbcnt_hi(~0u, __builtin_amdgcn_mbcnt_lo(~0u, z)));
  asm volatile("" : "+v"(t)); return t; }
__device__ __forceinline__ float swap16_sum(float x, float y) {
  const auto s = __builtin_amdgcn_permlane16_swap(__float_as_uint(x), __float_as_uint(y), false, false);
  const unsigned r0 = s[0], r1 = s[1];
  return __uint_as_float(r0) + __uint_as_float(r1);
}
__device__ __forceinline__ float swap32_sum(float x, float y) {
  const auto s = __builtin_amdgcn_permlane32_swap(__float_as_uint(x), __float_as_uint(y), false, false);
  const unsigned r0 = s[0], r1 = s[1];
  return __uint_as_float(r0) + __uint_as_float(r1);
}
__device__ __forceinline__ float wave_sum(float v) {
  v += dppf<0xB1>(v); v += dppf<0x4E>(v); v += dppf<0x141>(v); v += dppf<0x128>(v);
  v = swap16_sum(v, v); return swap32_sum(v, v);
}
__device__ __forceinline__ float xor16_max(float x) { const auto s = __builtin_amdgcn_permlane16_swap(__float_as_uint(x), __float_as_uint(x), false, false); const unsigned r0 = s[0], r1 = s[1]; return fmaxf(__uint_as_float(r0), __uint_as_float(r1)); }
__device__ __forceinline__ float xor32_max(float x) { const auto s = __builtin_amdgcn_permlane32_swap(__float_as_uint(x), __float_as_uint(x), false, false); const unsigned r0 = s[0], r1 = s[1]; return fmaxf(__uint_as_float(r0), __uint_as_float(r1)); }
__device__ __forceinline__ float wave_max(float v) {
  v = fmaxf(v, dppf<0xB1>(v)); v = fmaxf(v, dppf<0x4E>(v)); v = fmaxf(v, dppf<0x141>(v)); v = fmaxf(v, dppf<0x128>(v));
  return xor32_max(xor16_max(v));
}
__device__ __forceinline__ float gelu_tanh(float x) {
  const float u = 1.5957691216057308f * (x + 0.044715f * x * x * x);
  return x * __builtin_amdgcn_rcpf(1.0f + __expf(-u));
}
__device__ __forceinline__ float silu(float x) { return x * __builtin_amdgcn_rcpf(1.0f + __expf(-x)); }


#define XB_TMO      128
#define XB_XCNT(j)  (256  + 64 * (j))
#define XB_XSUB(j)  (1280 + 64 * (j))
#define XB_XGEN(j)  (2304 + 64 * (j))
#define XB_TOP      3328
#define XB_TOPGEN   3392
#define XCD_BAR_WORDS 3456
#define XB_SPIN_CAP (1u << 18)
__device__ __forceinline__ unsigned xb_ld(unsigned* p)              { return __hip_atomic_load(p, __ATOMIC_RELAXED, __HIP_MEMORY_SCOPE_AGENT); }
__device__ __forceinline__ unsigned xb_add(unsigned* p, unsigned v) { return __hip_atomic_fetch_add(p, v, __ATOMIC_RELAXED, __HIP_MEMORY_SCOPE_AGENT); }
__device__ __forceinline__ unsigned xb_xcc_id() { return (unsigned)__builtin_amdgcn_s_getreg((3 << 11) | 20) & 0xFu; }
#define XB_SPIN(cond, bar) do { unsigned _sp = 0; while (cond) { __builtin_amdgcn_s_sleep(1); \
    if ((++_sp & 255u) == 0u) { if (xb_ld(&(bar)[XB_TMO])) break; if (_sp > XB_SPIN_CAP) { atomicAdd(&(bar)[XB_TMO], 1u); break; } } } } while (0)
struct XcdBarrier { unsigned* bar; unsigned x; volatile LAS unsigned* st; };
__device__ __forceinline__ XcdBarrier xcd_barrier_post(unsigned* bar, volatile LAS unsigned* st) {
  XcdBarrier b; b.bar = bar; b.x = xb_xcc_id(); b.st = st;
  if (opaque_tid() == 0) (void)xb_add(&bar[XB_XCNT(b.x)], 1u);
  return b;
}
__device__ __forceinline__ void xcd_barrier_complete(unsigned* bar, unsigned x, unsigned& nloc, unsigned& nx) {
  const unsigned G = gridDim.x * gridDim.y * gridDim.z;
  unsigned sum, cnt, mine, sp = 0u;
  for (;;) {
    sum = 0u; cnt = 0u; mine = 0u;
#pragma unroll
    for (unsigned j = 0; j < 16; ++j) { const unsigned c = xb_ld(&bar[XB_XCNT(j)]); sum += c; cnt += (c > 0u) ? 1u : 0u; mine = (j == x) ? c : mine; }
    if (sum == G) break;
    __builtin_amdgcn_s_sleep(1);
    if ((++sp & 255u) == 0u) { if (xb_ld(&bar[XB_TMO])) break; if (sp > XB_SPIN_CAP) { atomicAdd(&bar[XB_TMO], 1u); break; } }
  }
  nloc = mine > 0u ? mine : 1u; nx = cnt > 0u ? cnt : 1u;
}
__device__ __forceinline__ void xcd_barrier(const XcdBarrier& b) {
  asm volatile("s_waitcnt vmcnt(0)" ::: "memory");
  __syncthreads();
  if (opaque_tid() == 0) {
    unsigned* bar = b.bar;
    __builtin_amdgcn_s_waitcnt(0);
    unsigned nloc = b.st[0], nx = b.st[1];
    if (nloc == 0u) { xcd_barrier_complete(bar, b.x, nloc, nx); b.st[0] = nloc; b.st[1] = nx; }
    const unsigned old = xb_add(&bar[XB_XSUB(b.x)], 1u);
    const unsigned gen = old / nloc;
    if (old + 1u == (gen + 1u) * nloc) {
      __builtin_amdgcn_fence(__ATOMIC_RELEASE, "agent");
      asm volatile("s_waitcnt vmcnt(0)" ::: "memory");
      const unsigned og = xb_add(&bar[XB_TOP], 1u);
      const unsigned tg = og / nx;
      if (og + 1u == (tg + 1u) * nx) xb_add(&bar[XB_TOPGEN], 1u);
      else XB_SPIN(xb_ld(&bar[XB_TOPGEN]) == tg, bar);
      __builtin_amdgcn_fence(__ATOMIC_ACQUIRE, "agent");
      xb_add(&bar[XB_XGEN(b.x)], 1u);
      asm volatile("s_waitcnt vmcnt(0)" ::: "memory");
    } else {
      XB_SPIN(xb_ld(&bar[XB_XGEN(b.x)]) == gen, bar);
      __builtin_amdgcn_fence(__ATOMIC_ACQUIRE, "agent");
      asm volatile("s_waitcnt vmcnt(0)" ::: "memory");
    }
  }
  __syncthreads();
}

namespace pg8 {
constexpr int BM = 256, BK = 64, HALF = 128, HTB = HALF * BK * 2, STAGE_BYTES = 8 * HTB, NXCD = 8, WGM = 8;
__device__ __forceinline__ int lds_byte(int r, int c) { const int st = (r >> 4) * 2 + (c >> 5), rr = r & 15, cc = c & 31, ob = rr * 64 + cc * 2; return st * 1024 + (ob ^ (((ob >> 9) & 1) << 5)); }
__device__ __forceinline__ void stage_rc(int b, int& R, int& C) { const int st = b / 1024, sb = b % 1024, swz = sb ^ (((sb >> 9) & 1) << 5); R = (st >> 1) * 16 + swz / 64; C = (st & 1) * 32 + (swz % 64) / 2; }
__device__ __forceinline__ int perm32(int rho) { const int n = rho >> 4, i = rho & 15; return 8 * (i >> 2) + 4 * n + (i & 3); }
struct Unit { int pm, pn; };
struct Gemm { const bf16_t* A; const bf16_t* Bt; int lda, K, acol; };
struct StaticOrder {
  int nM, nN, nwg, G, c;
  __device__ void init(int M, int N, int G_, int c_) { nM = M / BM; nN = N / BM; nwg = nM * nN; G = G_; c = c_; }
  __device__ bool next(int i, Unit& u) const {
    const long L = (long)i * G + c; if (L >= nwg) return false;
    int wgid = (int)L; { const int q = nwg / NXCD, r = nwg % NXCD, xcd = wgid % NXCD, off = wgid / NXCD; wgid = (xcd < r ? xcd * (q + 1) : r * (q + 1) + (xcd - r) * q) + off; }
    const int nig = WGM * nN, gid = wgid / nig, fm = gid * WGM, gsz = (nM - fm) < WGM ? (nM - fm) : WGM;
    u.pm = fm + ((wgid % nig) % gsz); u.pn = (wgid % nig) / gsz; return true;
  }
};
struct OrderG1 {
  StaticOrder so;
  __device__ bool next(int i, Unit& u) const {
    if (so.next(i, u)) return true;
    const long L = (long)i * so.G + so.c;
    if (L >= so.nwg && L < so.nwg + 2) { u.pm = 128 + (int)(L - so.nwg); u.pn = 2; return true; }
    return false;
  }
};

template <class Epi, class Sched>
__device__ __forceinline__ void gemm_phase(LAS unsigned char* lds, const Gemm g, const Sched& S, const Epi& E) {
  const int tid = opaque_tid(), wid = __builtin_amdgcn_readfirstlane(tid >> 6), lane = tid & 63, wr = wid >> 2, wc = wid & 3, fr = lane & 15, fq = lane >> 4;
  const int K = g.K, nt = K / BK;
  unsigned voffA[2], voffB[2];
#pragma unroll
  for (int i = 0; i < 2; ++i) { int R, C; stage_rc(tid * 16 + i * 8192, R, C); const int Rb = Epi::PERM ? ((R & ~31) + perm32(R & 31)) : R;
    voffA[i] = (unsigned)(R * g.lda + C) * 2u; voffB[i] = (unsigned)(Rb * K + C) * 2u; }
  const size_t kstep = (size_t)(BK * 2);
  const size_t hstepA = (size_t)HALF * g.lda * 2, hstepB = (size_t)HALF * K * 2;
  const size_t tstepA = 2 * hstepA, tstepB = 2 * hstepB;
  const unsigned ldsw = (unsigned)wid * 1024u;
  const int aoff = lds_byte(wr * 64 + fr, fq * 8), boff = lds_byte(wc * 32 + fr, fq * 8);
#define PG8_SA(b, h) (((b) * 2 + (h)) * HTB)
#define PG8_SB(b, h) ((4 + (b) * 2 + (h)) * HTB)
#define PG8_STAGE(bufoff, gbase, voff) do { _Pragma("unroll") for (int _i = 0; _i < 2; ++_i) \
    __builtin_amdgcn_global_load_lds((const unsigned*)((const char*)(gbase) + (voff)[_i]), (LAS unsigned*)(lds + (bufoff) + ldsw + _i * 8192), 16, 0, 0); } while (0)
#define PG8_LDA(dst, b, h) do { _Pragma("unroll") for (int m = 0; m < 4; ++m) _Pragma("unroll") for (int k = 0; k < 2; ++k) dst[m][k] = *(const LAS bf16x8*)(lds + PG8_SA(b, h) + aoff + m * 2048 + k * 1024); } while (0)
#define PG8_LDB(dst, b, h) do { _Pragma("unroll") for (int n = 0; n < 2; ++n) _Pragma("unroll") for (int k = 0; k < 2; ++k) dst[n][k] = *(const LAS bf16x8*)(lds + PG8_SB(b, h) + boff + n * 2048 + k * 1024); } while (0)
#define PG8_MMA(ai, bj, At, Bt) do { __builtin_amdgcn_s_setprio(1); _Pragma("unroll") for (int m = 0; m < 4; ++m) _Pragma("unroll") for (int n = 0; n < 2; ++n) _Pragma("unroll") for (int k = 0; k < 2; ++k) \
    acc[ai][bj][m][n] = __builtin_amdgcn_mfma_f32_16x16x32_bf16(Bt[n][k], At[m][k], acc[ai][bj][m][n], 0, 0, 0); __builtin_amdgcn_s_setprio(0); } while (0)
#define PG8_WAIT_V(n) asm volatile("s_waitcnt vmcnt(" #n ")" ::: "memory")
#define PG8_WAIT_L(n) asm volatile("s_waitcnt lgkmcnt(" #n ")" ::: "memory")
#define PG8_BAR __builtin_amdgcn_s_barrier()
#define PG8_SCHED __builtin_amdgcn_sched_barrier(0)
  Unit cur, nxt; int ui = 0;
  if (!S.next(0, cur)) return;
  f32x4 acc[2][2][4][2];
#pragma unroll
  for (int a = 0; a < 2; ++a)
#pragma unroll
    for (int b = 0; b < 2; ++b)
#pragma unroll
      for (int m = 0; m < 4; ++m)
#pragma unroll
        for (int n = 0; n < 2; ++n) acc[a][b][m][n] = (f32x4){0.f, 0.f, 0.f, 0.f};
  bf16x8 At[4][2], B0[2][2], B1[2][2];
  const char* cA = (const char*)g.A + (size_t)cur.pm * tstepA + (size_t)cur.pn * g.acol * 2; const char* cB = (const char*)g.Bt + (size_t)cur.pn * tstepB;
  PG8_STAGE(PG8_SB(0, 0), cB, voffB); PG8_STAGE(PG8_SA(0, 0), cA, voffA); PG8_STAGE(PG8_SB(0, 1), cB + hstepB, voffB); PG8_STAGE(PG8_SA(0, 1), cA + hstepA, voffA);
  if (wr == 1) PG8_BAR;
  PG8_WAIT_V(4); PG8_BAR;
  PG8_STAGE(PG8_SB(1, 0), cB + kstep, voffB); PG8_STAGE(PG8_SA(1, 0), cA + kstep, voffA); PG8_STAGE(PG8_SB(1, 1), cB + hstepB + kstep, voffB);
  PG8_WAIT_V(6); PG8_BAR;
  for (;;) {
    const bool has_next = S.next(ui + 1, nxt);
    const char* nA = has_next ? (const char*)g.A + (size_t)nxt.pm * tstepA + (size_t)nxt.pn * g.acol * 2 : cA; const char* nB = has_next ? (const char*)g.Bt + (size_t)nxt.pn * tstepB : cB;
#pragma unroll 1
    for (int t = 0; t < nt; t += 2) {
      const bool last = (t == nt - 2);
      const char* a1 = cA + (size_t)(t + 1) * kstep;
      const char* a2 = last ? nA : cA + (size_t)(t + 2) * kstep; const char* b2 = last ? nB : cB + (size_t)(t + 2) * kstep;
      const char* a3 = a2 + kstep; const char* b3 = b2 + kstep;
      PG8_LDB(B0, 0, 0); PG8_SCHED; PG8_LDA(At, 0, 0); PG8_STAGE(PG8_SA(1, 1), a1 + hstepA, voffA);
      PG8_WAIT_L(8); PG8_BAR; PG8_WAIT_L(0); PG8_MMA(0, 0, At, B0); PG8_BAR; PG8_SCHED;
      PG8_LDB(B1, 0, 1); PG8_STAGE(PG8_SB(0, 0), b2, voffB);
      PG8_BAR; PG8_WAIT_L(0); PG8_MMA(0, 1, At, B1); PG8_BAR;
      PG8_LDA(At, 0, 1); PG8_STAGE(PG8_SA(0, 0), a2, voffA);
      PG8_BAR; PG8_WAIT_L(0); PG8_MMA(1, 0, At, B0); PG8_BAR; PG8_SCHED;
      PG8_STAGE(PG8_SB(0, 1), b2 + hstepB, voffB);
      PG8_WAIT_V(6); PG8_BAR; PG8_MMA(1, 1, At, B1); PG8_BAR;
      PG8_LDB(B0, 1, 0); PG8_SCHED; PG8_LDA(At, 1, 0); PG8_STAGE(PG8_SA(0, 1), a2 + hstepA, voffA);
      PG8_WAIT_L(8); PG8_BAR; PG8_WAIT_L(0); PG8_MMA(0, 0, At, B0); PG8_BAR; PG8_SCHED;
      PG8_LDB(B1, 1, 1); PG8_STAGE(PG8_SB(1, 0), b3, voffB);
      PG8_BAR; PG8_WAIT_L(0); PG8_MMA(0, 1, At, B1); PG8_BAR;
      PG8_LDA(At, 1, 1); PG8_STAGE(PG8_SA(1, 0), a3, voffA);
      PG8_BAR; PG8_WAIT_L(0); PG8_MMA(1, 0, At, B0); PG8_BAR; PG8_SCHED;
      PG8_STAGE(PG8_SB(1, 1), b3 + hstepB, voffB);
      PG8_WAIT_V(6); PG8_BAR; PG8_MMA(1, 1, At, B1); PG8_BAR;
    }
    E(acc, cur, wr, wc, fr, fq);
    if (!has_next) break;
#pragma unroll
    for (int a = 0; a < 2; ++a)
#pragma unroll
      for (int b = 0; b < 2; ++b)
#pragma unroll
        for (int m = 0; m < 4; ++m)
#pragma unroll
          for (int n = 0; n < 2; ++n) acc[a][b][m][n] = (f32x4){0.f, 0.f, 0.f, 0.f};
    cur = nxt; cA = nA; cB = nB; ++ui;
  }
  PG8_WAIT_V(0);
  if (wr == 0) PG8_BAR;
  PG8_BAR;
#undef PG8_SA
#undef PG8_SB
#undef PG8_STAGE
#undef PG8_LDA
#undef PG8_LDB
#undef PG8_MMA
#undef PG8_WAIT_V
#undef PG8_WAIT_L
#undef PG8_BAR
#undef PG8_SCHED
}
}

struct EpiG1 {
  static constexpr bool PERM = false;
  bf16_t *Qb, *Kb, *VT, *KC, *VCT, *Ub, *GT; const float* rope;
  __device__ __forceinline__ void operator()(const f32x4 (&acc)[2][2][4][2], const pg8::Unit& u, int wr, int wc, int fr, int fq) const {
    const int pn = u.pn;
    if (u.pm >= 128) {
#pragma unroll
      for (int ai = 0; ai < 2; ++ai)
#pragma unroll
        for (int m = 0; m < 4; ++m) {
          const int tc = (u.pm - 128) * 256 + 128 * ai + 64 * wr + 16 * m + fr, b = tc >> 8, cp = tc & 255;
#pragma unroll
          for (int n = 0; n < 2; ++n) {
            const f32x4 kv = acc[ai][0][m][n]; const int cc = 32 * wc + 16 * n + 4 * fq;
            u32x2 w; w.x = pk2(kv[0], kv[1]); w.y = pk2(kv[2], kv[3]); *(u32x2*)(KC + (size_t)tc * 128 + cc) = w;
            const f32x4 vv = acc[ai][1][m][n]; const int g = cc >> 6, d = cc & 63;
#pragma unroll
            for (int j = 0; j < 4; ++j) VCT[((size_t)((b * 2 + g) * 64 + d + j)) * 256 + cp] = (bf16_t)(pk2(vv[j], 0.f) & 0xffffu);
          }
        }
      return;
    }
#pragma unroll
    for (int ai = 0; ai < 2; ++ai)
#pragma unroll
      for (int m = 0; m < 4; ++m) {
        const int t = u.pm * 256 + 128 * ai + 64 * wr + 16 * m + fr, s = t & (SEQL - 1), b = t >> 14;
        if (pn <= 2) {
          const int pos = (wc & 1) ? (s & 63) : (s >> 6);
          const f32x4 cs = *(const f32x4*)(rope + pos * 16 + 4 * fq), sn = *(const f32x4*)(rope + 4096 + pos * 16 + 4 * fq);
#pragma unroll
          for (int bj = 0; bj < 2; ++bj) {
            const f32x4 x1 = acc[ai][bj][m][0], x2 = acc[ai][bj][m][1];
            if (pn < 2) {
              const f32x4 o1 = (x1 * cs - x2 * sn) * 0.18033688f, o2 = (x1 * sn + x2 * cs) * 0.18033688f;
              bf16_t* dst = Qb + (size_t)t * 512 + pn * 256 + 128 * bj + 32 * wc + 4 * fq;
              u32x2 w; w.x = pk2(o1[0], o1[1]); w.y = pk2(o1[2], o1[3]); *(u32x2*)dst = w;
              w.x = pk2(o2[0], o2[1]); w.y = pk2(o2[2], o2[3]); *(u32x2*)(dst + 16) = w;
            } else if (bj == 0) {
              const f32x4 o1 = x1 * cs - x2 * sn, o2 = x1 * sn + x2 * cs;
              bf16_t* dst = Kb + (size_t)t * 128 + 32 * wc + 4 * fq;
              u32x2 w; w.x = pk2(o1[0], o1[1]); w.y = pk2(o1[2], o1[3]); *(u32x2*)dst = w;
              w.x = pk2(o2[0], o2[1]); w.y = pk2(o2[2], o2[3]); *(u32x2*)(dst + 16) = w;
            } else {
#pragma unroll
              for (int n = 0; n < 2; ++n) {
                const f32x4 vv = n ? x2 : x1; const int cc = 32 * wc + 16 * n + 4 * fq, g = cc >> 6, d = cc & 63;
#pragma unroll
                for (int j = 0; j < 4; ++j) VT[((size_t)((b * 2 + g) * 64 + d + j)) * SEQL + s] = (bf16_t)(pk2(vv[j], 0.f) & 0xffffu);
              }
            }
          }
        } else if (pn <= 4) {
#pragma unroll
          for (int bj = 0; bj < 2; ++bj)
#pragma unroll
            for (int n = 0; n < 2; ++n) {
              const f32x4 v = acc[ai][bj][m][n];
              u32x2 w; w.x = pk2(gelu_tanh(v[0]), gelu_tanh(v[1])); w.y = pk2(gelu_tanh(v[2]), gelu_tanh(v[3]));
              *(u32x2*)(Ub + (size_t)t * 512 + (pn - 3) * 256 + 128 * bj + 32 * wc + 16 * n + 4 * fq) = w;
            }
        } else {
          const int tb = t >> 7, q = t & 127;
#pragma unroll
          for (int bj = 0; bj < 2; ++bj)
#pragma unroll
            for (int n = 0; n < 2; ++n) {
              const f32x4 v = acc[ai][bj][m][n]; const int cc = (pn - 5) * 256 + 128 * bj + 32 * wc + 16 * n + 4 * fq, grp = cc >> 6, d = cc & 63;
#pragma unroll
              for (int j = 0; j < 4; ++j) GT[((size_t)((tb * 8 + grp) * 64 + d + j)) * 128 + q] = (bf16_t)(pk2(gelu_tanh(v[j]), 0.f) & 0xffffu);
            }
        }
      }
  }
};
struct EpiBf16 {
  static constexpr bool PERM = true;
  bf16_t* O; int ldc;
  __device__ __forceinline__ void operator()(const f32x4 (&acc)[2][2][4][2], const pg8::Unit& u, int wr, int wc, int fr, int fq) const {
    const int col0 = u.pn * 256 + wc * 32 + 8 * fq;
#pragma unroll
    for (int ai = 0; ai < 2; ++ai)
#pragma unroll
      for (int m = 0; m < 4; ++m) { bf16_t* rowp = O + (size_t)(u.pm * 256 + 128 * ai + 64 * wr + 16 * m + fr) * ldc + col0;
#pragma unroll
        for (int bj = 0; bj < 2; ++bj) { const f32x4 v0 = acc[ai][bj][m][0], v1 = acc[ai][bj][m][1];
          u32x4 w; w.x = pk2(v0[0], v0[1]); w.y = pk2(v0[2], v0[3]); w.z = pk2(v1[0], v1[1]); w.w = pk2(v1[2], v1[3]); *(u32x4*)(rowp + bj * 128) = w; } }
  }
};

struct EpiF16 {
  static constexpr bool PERM = true;
  unsigned short* O; int ldc;
  __device__ __forceinline__ void operator()(const f32x4 (&acc)[2][2][4][2], const pg8::Unit& u, int wr, int wc, int fr, int fq) const {
    const int col0 = u.pn * 256 + wc * 32 + 8 * fq;
#pragma unroll
    for (int ai = 0; ai < 2; ++ai)
#pragma unroll
      for (int m = 0; m < 4; ++m) { unsigned short* rowp = O + (size_t)(u.pm * 256 + 128 * ai + 64 * wr + 16 * m + fr) * ldc + col0;
#pragma unroll
        for (int bj = 0; bj < 2; ++bj) { const f32x4 v0 = acc[ai][bj][m][0], v1 = acc[ai][bj][m][1];
          u32x4 w; w.x = __builtin_bit_cast(unsigned, __builtin_amdgcn_cvt_pkrtz(v0[0], v0[1])); w.y = __builtin_bit_cast(unsigned, __builtin_amdgcn_cvt_pkrtz(v0[2], v0[3]));
          w.z = __builtin_bit_cast(unsigned, __builtin_amdgcn_cvt_pkrtz(v1[0], v1[1])); w.w = __builtin_bit_cast(unsigned, __builtin_amdgcn_cvt_pkrtz(v1[2], v1[3])); *(u32x4*)(rowp + bj * 128) = w; } }
  }
};

__device__ __forceinline__ void transpose_item(const float* W, int K, int N, bf16_t* WT, LAS float* scr, int item, int lane) {
  const int nblk = N / 32, kb = item / nblk, nb = item % nblk, k0 = 64 * kb, n0 = 32 * nb;
#pragma unroll 8
  for (int i = 0; i < 32; ++i) { const int kk = 2 * i + (lane >> 5); scr[kk * 33 + (lane & 31)] = W[(size_t)(k0 + kk) * N + n0 + (lane & 31)]; }
  asm volatile("s_waitcnt lgkmcnt(0)" ::: "memory");
  const int c = lane & 7;
#pragma unroll
  for (int j = 0; j < 4; ++j) { const int n = (lane >> 3) + 8 * j; const LAS float* s = scr + (8 * c) * 33 + n;
    u32x4 o; o.x = pk2(s[0 * 33], s[1 * 33]); o.y = pk2(s[2 * 33], s[3 * 33]); o.z = pk2(s[4 * 33], s[5 * 33]); o.w = pk2(s[6 * 33], s[7 * 33]);
    *(u32x4*)(WT + (size_t)(n0 + n) * K + k0 + 8 * c) = o; }
  asm volatile("s_waitcnt lgkmcnt(0)" ::: "memory");
}
__device__ __forceinline__ void convert_bf16(const float* src, bf16_t* dst, size_t n8, size_t i0, size_t stride) {
  for (size_t i = i0; i < n8; i += stride) { const f32x4 a = *(const f32x4*)(src + i * 8), b = *(const f32x4*)(src + i * 8 + 4);
    u32x4 o; o.x = pk2(a[0], a[1]); o.y = pk2(a[2], a[3]); o.z = pk2(b[0], b[1]); o.w = pk2(b[2], b[3]); *(u32x4*)(dst + i * 8) = o; }
}
__device__ __forceinline__ void convert_tables(const Params& p, int layer, int worker, int nworkers, int lane) {
  unsigned char* ws = p.ws;
  constexpr int RB = 4;
#pragma unroll 1
  for (int row0 = worker; row0 < 2 * NEXP; row0 += RB * nworkers) {
    f32x4 v[RB][4];
#pragma unroll
    for (int q = 0; q < RB; ++q) { const int row = min(row0 + q * nworkers, 2 * NEXP - 1); const int up = row >> 14, le = layer * NEXP + (row & (NEXP - 1));
      const f32x4* src = (const f32x4*)((up ? p.peer_up : p.peer_down) + (size_t)le * DM) + lane;
#pragma unroll
      for (int j = 0; j < 4; ++j) v[q][j] = src[64 * j]; }
#pragma unroll
    for (int q = 0; q < RB; ++q) { const int row = row0 + q * nworkers; if (row >= 2 * NEXP) break;
      const int up = row >> 14, e = row & (NEXP - 1), le = layer * NEXP + e;
      float am = 0.f;
#pragma unroll
      for (int j = 0; j < 4; ++j) am = fmaxf(am, fmaxf(fmaxf(fabsf(v[q][j][0]), fabsf(v[q][j][1])), fmaxf(fabsf(v[q][j][2]), fabsf(v[q][j][3]))));
      am = wave_max(am);
      const float inv4 = am > 0.f ? 6.0f / am : 0.f;
      unsigned char* d4 = ws + (up ? WS_TU4 : WS_TD4) + (size_t)layer * NEXP * 512 + (size_t)e * 128 + 2 * lane;
#pragma unroll
      for (int j = 0; j < 4; ++j) { unsigned w = __builtin_amdgcn_cvt_scalef32_pk_fp4_f32(0u, v[q][j][0] * inv4, v[q][j][1] * inv4, 1.0f, 0);
        w = __builtin_amdgcn_cvt_scalef32_pk_fp4_f32(w, v[q][j][2] * inv4, v[q][j][3] * inv4, 1.0f, 1);
        *(unsigned short*)(d4 + (size_t)j * NEXP * 128) = (unsigned short)w; }
      if (lane == 0) ((float*)(ws + (up ? WS_SU : WS_SD)))[le] = am * (1.0f / 6.0f);
    }
  }
}

__device__ __forceinline__ void phase_prep(const Params& p, LAS unsigned char* lds) {
  const int tid = opaque_tid(), lane = tid & 63, wave = tid >> 6;
  unsigned char* ws = p.ws;
  if (blockIdx.x < 192) {
    const int layer = blockIdx.x / 96, col = (blockIdx.x % 96) * 64 + (tid & 63), kg = tid >> 6;
    const float* W = p.mod_w + (size_t)layer * DM * 6144;
    LAS float* sv = (LAS float*)(lds + 8192);
    for (int i = tid; i < 3 * DM; i += NTHREADS) sv[i] = silu(i < 2 * DM ? p.c[i] : p.c_ctx[i - 2 * DM]);
    __syncthreads();
    float a0 = 0.f, a1 = 0.f, a2 = 0.f;
#pragma unroll 8
    for (int k = kg * 128; k < kg * 128 + 128; ++k) {
      const float w = W[(size_t)k * 6144 + col];
      a0 += sv[k] * w; a1 += sv[DM + k] * w; a2 += sv[2 * DM + k] * w;
    }
    LAS float* red = (LAS float*)lds;
    red[(kg * 3 + 0) * 64 + (tid & 63)] = a0; red[(kg * 3 + 1) * 64 + (tid & 63)] = a1; red[(kg * 3 + 2) * 64 + (tid & 63)] = a2;
    __syncthreads();
    if (tid < 192) { const int v = tid >> 6, cc = tid & 63; float sacc = 0.f;
#pragma unroll
      for (int g = 0; g < 8; ++g) sacc += red[(g * 3 + v) * 64 + cc];
      const int colg = (blockIdx.x % 96) * 64 + cc; sacc += p.mod_b[layer * 6144 + colg];
      float* MOD = (float*)(ws + WS_MOD);
      if (layer == 0) MOD[v * 6144 + colg] = sacc; else if (v < 2) MOD[(3 + v) * 6144 + colg] = sacc; }
    __syncthreads();
  }
  { const int i = blockIdx.x * NTHREADS + tid; if (i < 4096) { const int pos = i >> 4, f = i & 15; const float inv = powf(10000.0f, -(float)f / 16.0f), ang = (float)pos * inv;
      float* R = (float*)(ws + WS_ROPE); R[i] = cosf(ang); R[4096 + i] = sinf(ang); } }
  { LAS float* scr = (LAS float*)(lds + 8192 + wave * 8448);
    const int gw = blockIdx.x * NWAVES + wave, NGW = gridDim.x * NWAVES;
    constexpr int I_IN = 16 * 56, I_OUT = 16 * 32, I_Q = 16 * 64, I_P = 4 * 8;
    constexpr int NITEMS = I_IN + I_OUT + 4 * I_P;
    for (int it = gw; it < NITEMS; it += NGW) {
      int r = it;
      if (r < I_IN) { transpose_item(p.attn_in_w, DM, INW, (bf16_t*)(ws + WS_WIN), scr, r, lane); continue; } r -= I_IN;
      if (r < I_OUT) { transpose_item(p.attn_out_w, DM, DM, (bf16_t*)(ws + WS_WOUT), scr, r, lane); continue; } r -= I_OUT;
      const int g = r / I_P; r -= g * I_P;
      transpose_item(p.pool_w + (size_t)g * 256 * 256, 256, 256, (bf16_t*)(ws + WS_WPOOL) + (size_t)g * 256 * 256, scr, r, lane);
    }
  }
  { LAS float* As = (LAS float*)lds; LAS float* Ss = (LAS float*)(lds + 64 * 132 * 4);
    __syncthreads();
    for (int item = blockIdx.x; item < 2 * 16 * 16; item += gridDim.x) {
      const int kb = item & 15, hp = (item >> 4) & 15, l = item >> 8, pp = hp & 1;
      __syncthreads();
      f32x4 stg[12];
#pragma unroll
      for (int u = 0; u < 4; ++u) { const int i = tid + u * NTHREADS, row = i >> 5, c4 = i & 31;
        stg[u] = *(const f32x4*)(p.peer_w_q + ((size_t)l * DM + kb * 64 + row) * 2048 + hp * 128 + c4 * 4); }
#pragma unroll
      for (int u = 0; u < 8; ++u) { const int i = tid + u * NTHREADS, row = i >> 5, c4 = i & 31;
        stg[4 + u] = *(const f32x4*)(p.peer_sub_keys + (((size_t)l * 2 + pp) * 128 + row) * 128 + c4 * 4); }
#pragma unroll
      for (int u = 0; u < 4; ++u) { const int i = tid + u * NTHREADS, row = i >> 5, c4 = i & 31; *(LAS f32x4*)(As + row * 132 + c4 * 4) = stg[u]; }
#pragma unroll
      for (int u = 0; u < 8; ++u) { const int i = tid + u * NTHREADS, row = i >> 5, c4 = i & 31; *(LAS f32x4*)(Ss + row * 132 + c4 * 4) = stg[4 + u]; }
      __syncthreads();
      { const int li = lane & 15, g = lane >> 4;
        f32x4 dacc[4];
#pragma unroll
        for (int q = 0; q < 4; ++q) dacc[q] = (f32x4){0.f, 0.f, 0.f, 0.f};
#pragma unroll
        for (int s8 = 0; s8 < 8; ++s8) {
          const f32x4 sa = *(const LAS f32x4*)(Ss + (16 * wave + li) * 132 + 32 * g + 4 * s8);
          f32x4 ab[4];
#pragma unroll
          for (int q = 0; q < 4; ++q) ab[q] = *(const LAS f32x4*)(As + (16 * q + li) * 132 + 32 * g + 4 * s8);
#pragma unroll
          for (int e = 0; e < 4; ++e)
#pragma unroll
            for (int q = 0; q < 4; ++q) dacc[q] = __builtin_amdgcn_mfma_f32_16x16x4f32(sa[e], ab[q][e], dacc[q], 0, 0, 0);
        }
        bf16_t* dstb = (bf16_t*)(ws + WS_WQ) + ((size_t)l * 2048 + hp * 128 + 16 * wave + 4 * g) * DM + kb * 64 + li;
#pragma unroll
        for (int q = 0; q < 4; ++q)
#pragma unroll
          for (int r = 0; r < 4; ++r) dstb[(size_t)r * DM + 16 * q] = (bf16_t)(pk2(dacc[q][r], 0.f) & 0xffffu);
      }
    }
    __syncthreads();
  }
  { const size_t i0 = (size_t)blockIdx.x * NTHREADS + tid, stride = (size_t)gridDim.x * NTHREADS;
    convert_bf16(p.gmlp_w_s, (bf16_t*)(ws + WS_WS), 8 * 128 * 128 / 8, i0, stride);
  }
  convert_tables(p, 0, blockIdx.x * NWAVES + wave, gridDim.x * NWAVES, lane);
}

__device__ __forceinline__ void resid_norm_phase(const Params& p, int layer) {
  unsigned char* ws = p.ws;
  const int tid = opaque_tid(), lane = tid & 63, wave = tid >> 6;
  const int gw = blockIdx.x * NWAVES + wave, NGW = gridDim.x * NWAVES;
  const float* MOD = (const float*)(ws + WS_MOD); bf16_t* H = (bf16_t*)(ws + WS_H); const bf16_t* Y = (const bf16_t*)(ws + WS_Y);
  bf16_t* XR = (bf16_t*)(ws + WS_XR); const float* ng = p.norm2_g + layer * DM;
  constexpr int RB = 4;
#pragma unroll 1
  for (int b = 0; b < NB; ++b) {
    const float* m = MOD + (size_t)(layer == 0 ? b : 3 + b) * 6144;
    f32x4 G[4], A[4], B[4];
#pragma unroll
    for (int j = 0; j < 4; ++j) { G[j] = ((const f32x4*)(m + 2 * DM))[lane + 64 * j]; if (layer == 1) G[j] = G[j] * ((const f32x4*)p.pool_scale)[lane + 64 * j];
      A[j] = ((const f32x4*)ng)[lane + 64 * j] * (((const f32x4*)(m + 4 * DM))[lane + 64 * j] + 1.0f); B[j] = ((const f32x4*)(m + 3 * DM))[lane + 64 * j]; }
#pragma unroll 1
    for (int r0 = b * SEQL + gw; r0 < (b + 1) * SEQL; r0 += RB * NGW) {
      f32x4 v[RB][4]; u32x2 yw[RB][4];
#pragma unroll
      for (int q = 0; q < RB; ++q) { const int r = min(r0 + q * NGW, (b + 1) * SEQL - 1);
        const u32x2* yr = (const u32x2*)(Y + (size_t)r * DM) + lane;
        if (layer == 0) { const f32x4* xr = (const f32x4*)(p.x + (size_t)r * DM) + lane;
#pragma unroll
          for (int j = 0; j < 4; ++j) { v[q][j] = xr[64 * j]; yw[q][j] = yr[64 * j]; } }
        else { const u32x2* xr = (const u32x2*)(XR + (size_t)r * DM) + lane;
#pragma unroll
          for (int j = 0; j < 4; ++j) { const u32x2 w = xr[64 * j]; v[q][j] = (f32x4){bf_lo(w.x), bf_hi(w.x), bf_lo(w.y), bf_hi(w.y)}; yw[q][j] = yr[64 * j]; } } }
#pragma unroll
      for (int q = 0; q < RB; ++q) { const int r = r0 + q * NGW; if (r >= (b + 1) * SEQL) break;
        float ss = 0.f;
#pragma unroll
        for (int j = 0; j < 4; ++j) { const f32x4 yy = (f32x4){bf_lo(yw[q][j].x), bf_hi(yw[q][j].x), bf_lo(yw[q][j].y), bf_hi(yw[q][j].y)};
          v[q][j] = v[q][j] + G[j] * yy; ss += (v[q][j][0] * v[q][j][0] + v[q][j][1] * v[q][j][1]) + (v[q][j][2] * v[q][j][2] + v[q][j][3] * v[q][j][3]); }
        const float rr = rsqrtf(wave_sum(ss) * (1.0f / DM) + 1e-6f);
        u32x2* xo = (u32x2*)(XR + (size_t)r * DM) + lane; u32x2* o8 = (u32x2*)(H + (size_t)r * DM) + lane;
#pragma unroll
        for (int j = 0; j < 4; ++j) { { u32x2 w; w.x = pk2(v[q][j][0], v[q][j][1]); w.y = pk2(v[q][j][2], v[q][j][3]); xo[64 * j] = w; }
          const f32x4 y = (v[q][j] * rr) * A[j] + B[j]; u32x2 w; w.x = pk2(y[0], y[1]); w.y = pk2(y[2], y[3]); o8[64 * j] = w;
          float am = fmaxf(fmaxf(fabsf(y[0]), fabsf(y[1])), fmaxf(fabsf(y[2]), fabsf(y[3])));
          am = fmaxf(am, dppf<0xB1>(am)); am = fmaxf(am, dppf<0x4E>(am)); am = fmaxf(am, dppf<0x141>(am));
          const int s0 = max((int)(__float_as_uint(am) >> 23), 64) - 1;
          const float inv0 = __uint_as_float((unsigned)(254 - s0) << 23);
          const f32x2 fa = (f32x2){y[0], y[1]} * inv0, fb = (f32x2){y[2], y[3]} * inv0;
          unsigned w0 = __builtin_amdgcn_cvt_scalef32_pk_fp4_f32(0u, fa.x, fa.y, 1.0f, 0); w0 = __builtin_amdgcn_cvt_scalef32_pk_fp4_f32(w0, fb.x, fb.y, 1.0f, 1);
          const f32x2 ra = (fa - __builtin_amdgcn_cvt_scalef32_pk_f32_fp4(w0, 1.0f, 0)) * 4.0f, rb = (fb - __builtin_amdgcn_cvt_scalef32_pk_f32_fp4(w0, 1.0f, 1)) * 4.0f;
          unsigned w1 = __builtin_amdgcn_cvt_scalef32_pk_fp4_f32(0u, ra.x, ra.y, 1.0f, 0); w1 = __builtin_amdgcn_cvt_scalef32_pk_fp4_f32(w1, rb.x, rb.y, 1.0f, 1);
          unsigned char* hq = ws + WS_HQ + (size_t)r * 1024 + (8 * j + (lane >> 3)) * 16 + 2 * (lane & 7);
          *(unsigned short*)hq = (unsigned short)w0; *(unsigned short*)(hq + 512) = (unsigned short)w1;
          if ((lane & 7) == 0) (ws + WS_HS)[(size_t)r * 32 + 8 * j + (lane >> 3)] = (unsigned char)s0; }
      }
    }
  }
}

__device__ __forceinline__ int xcd_item(int rnd, int nitems) {
  const int G = gridDim.x;
  if ((G & 7) || (nitems & 7)) return (int)blockIdx.x + rnd * G;
  const int per = nitems >> 3, nb = G >> 3, j = (int)blockIdx.x >> 3, i = j + rnd * nb;
  return i < per ? ((int)blockIdx.x & 7) * per + i : nitems;
}
constexpr int KS_STRIDE = 144, VS_STRIDE = 272;
__device__ __forceinline__ void attn_phase(const Params& p, LAS unsigned char* lds) {
  unsigned char* ws = p.ws;
  const bf16_t* Qb = (const bf16_t*)(ws + WS_QB); const bf16_t* Kb = (const bf16_t*)(ws + WS_KB); const bf16_t* VT = (const bf16_t*)(ws + WS_VT);
  const bf16_t* KC = (const bf16_t*)(ws + WS_KC); const bf16_t* VCT = (const bf16_t*)(ws + WS_VCT); bf16_t* CAT = (bf16_t*)(ws + WS_CAT);
  const int tid = opaque_tid(), lane = tid & 63, wave = tid >> 6, fr = lane & 15, G = lane >> 4;
  LAS unsigned char* Ks = lds; LAS unsigned char* Vs = lds + 128 * KS_STRIDE;
  for (int rnd = 0, item = xcd_item(0, 1024); item < 1024; item = xcd_item(++rnd, 1024)) {
    const int half = item & 1, g = (item >> 1) & 1, n = (item >> 2) & 127, b = item >> 9;
    const int hq = g * 4 + half * 2 + (wave >> 2), q0 = n * 128 + (wave & 3) * 32;
    bf16x8 Qf[2][2];
#pragma unroll
    for (int qt = 0; qt < 2; ++qt)
#pragma unroll
      for (int ks = 0; ks < 2; ++ks) Qf[qt][ks] = *(const bf16x8*)(Qb + (size_t)(b * SEQL + q0 + qt * 16 + fr) * 512 + hq * 64 + ks * 32 + 8 * G);
    const float sink = p.attn_sink[hq] * 1.44269504f;
    float m_run[2] = {sink, sink}, l_run[2] = {1.0f, 1.0f};
    f32x4 O[4][2];
#pragma unroll
    for (int dt = 0; dt < 4; ++dt) { O[dt][0] = (f32x4){0.f, 0.f, 0.f, 0.f}; O[dt][1] = (f32x4){0.f, 0.f, 0.f, 0.f}; }
    u32x4 kreg[2], vreg[2];
    auto fetch = [&](int kb) {
      const int tile = n - 1 + kb;
#pragma unroll
      for (int i = 0; i < 2; ++i) {
        const int pc = tid + i * 512;
        { const int key = pc >> 3, ch = pc & 7;
          const bf16_t* src = (kb < 3) ? Kb + (size_t)(b * SEQL + tile * 128 + key) * 128 + g * 64 + ch * 8 : KC + (size_t)(b * CTXL + (kb - 3) * 128 + key) * 128 + g * 64 + ch * 8;
          kreg[i] = *(const u32x4*)src; }
        { const int d = pc >> 4, ch = pc & 15;
          const bf16_t* src = (kb < 3) ? VT + (size_t)((b * 2 + g) * 64 + d) * SEQL + tile * 128 + ch * 8 : VCT + (size_t)((b * 2 + g) * 64 + d) * CTXL + (kb - 3) * 128 + ch * 8;
          vreg[i] = *(const u32x4*)src; }
      }
    };
    const int kb_first = (n == 0) ? 1 : 0;
    fetch(kb_first);
    for (int kb = kb_first; kb < 5; ++kb) {
      const int tile = n - 1 + kb;
      if (kb == 2 && tile >= SEQL / 128) continue;
      __syncthreads();
#pragma unroll
      for (int i = 0; i < 2; ++i) { const int pc = tid + i * 512;
        *(LAS u32x4*)(Ks + (pc >> 3) * KS_STRIDE + (pc & 7) * 16) = kreg[i];
        *(LAS u32x4*)(Vs + (pc >> 4) * VS_STRIDE + (pc & 15) * 16) = vreg[i]; }
      { int kn = kb + 1; if (kn == 2 && n + 1 >= SEQL / 128) kn = 3; if (kn < 5) fetch(kn); }
      __syncthreads();
      f32x4 S[8][2];
#pragma unroll
      for (int kt = 0; kt < 8; ++kt) {
        S[kt][0] = (f32x4){0.f, 0.f, 0.f, 0.f}; S[kt][1] = (f32x4){0.f, 0.f, 0.f, 0.f};
#pragma unroll
        for (int ks = 0; ks < 2; ++ks) {
          const bf16x8 kf = *(const LAS bf16x8*)(Ks + (16 * kt + fr) * KS_STRIDE + ks * 64 + G * 16);
          S[kt][0] = __builtin_amdgcn_mfma_f32_16x16x32_bf16(kf, Qf[0][ks], S[kt][0], 0, 0, 0);
          S[kt][1] = __builtin_amdgcn_mfma_f32_16x16x32_bf16(kf, Qf[1][ks], S[kt][1], 0, 0, 0);
        }
      }
      if (kb == 0 || kb == 2) {
#pragma unroll
        for (int qt = 0; qt < 2; ++qt) { const int qpos = q0 + qt * 16 + fr;
#pragma unroll
          for (int kt = 0; kt < 8; ++kt)
#pragma unroll
            for (int r = 0; r < 4; ++r) { const int kpos = tile * 128 + 16 * kt + 4 * G + r; const bool ok = (kb == 0) ? (kpos >= qpos - 128) : (kpos <= qpos + 128);
              S[kt][qt][r] = ok ? S[kt][qt][r] : -INFINITY; } }
      }
      bf16x8 Pf[4][2];
#pragma unroll
      for (int qt = 0; qt < 2; ++qt) {
        float mx = S[0][qt][0];
#pragma unroll
        for (int kt = 0; kt < 8; ++kt)
#pragma unroll
          for (int r = 0; r < 4; ++r) mx = fmaxf(mx, S[kt][qt][r]);
        mx = xor32_max(xor16_max(mx));
        const float m_new = fmaxf(m_run[qt], mx), alpha = __builtin_amdgcn_exp2f(m_run[qt] - m_new);
        float rs = 0.f;
#pragma unroll
        for (int kt = 0; kt < 8; ++kt)
#pragma unroll
          for (int r = 0; r < 4; ++r) { const float e = __builtin_amdgcn_exp2f(S[kt][qt][r] - m_new); S[kt][qt][r] = e; rs += e; }
        rs = swap16_sum(rs, rs); rs = swap32_sum(rs, rs);
        l_run[qt] = l_run[qt] * alpha + rs; m_run[qt] = m_new;
#pragma unroll
        for (int dt = 0; dt < 4; ++dt) O[dt][qt] = O[dt][qt] * alpha;
#pragma unroll
        for (int s = 0; s < 4; ++s) { u32x4 w; w.x = pk2(S[2 * s][qt][0], S[2 * s][qt][1]); w.y = pk2(S[2 * s][qt][2], S[2 * s][qt][3]); w.z = pk2(S[2 * s + 1][qt][0], S[2 * s + 1][qt][1]); w.w = pk2(S[2 * s + 1][qt][2], S[2 * s + 1][qt][3]);
          Pf[s][qt] = *(bf16x8*)&w; }
      }
#pragma unroll
      for (int dt = 0; dt < 4; ++dt)
#pragma unroll
        for (int s = 0; s < 4; ++s) {
          const u32x2 v0 = *(const LAS u32x2*)(Vs + (16 * dt + fr) * VS_STRIDE + (32 * s + 4 * G) * 2), v1 = *(const LAS u32x2*)(Vs + (16 * dt + fr) * VS_STRIDE + (32 * s + 16 + 4 * G) * 2);
          u32x4 w; w.x = v0.x; w.y = v0.y; w.z = v1.x; w.w = v1.y; const bf16x8 vf = *(bf16x8*)&w;
          O[dt][0] = __builtin_amdgcn_mfma_f32_16x16x32_bf16(vf, Pf[s][0], O[dt][0], 0, 0, 0);
          O[dt][1] = __builtin_amdgcn_mfma_f32_16x16x32_bf16(vf, Pf[s][1], O[dt][1], 0, 0, 0);
        }
    }
#pragma unroll
    for (int qt = 0; qt < 2; ++qt) { const float inv = 1.0f / l_run[qt];
#pragma unroll
      for (int dt = 0; dt < 4; ++dt) { const f32x4 o = O[dt][qt] * inv; u32x2 w; w.x = pk2(o[0], o[1]); w.y = pk2(o[2], o[3]);
        *(u32x2*)(CAT + (size_t)(b * SEQL + q0 + qt * 16 + fr) * DM + hq * 64 + 16 * dt + 4 * G) = w; } }
  }
  __syncthreads();
}

__device__ __forceinline__ void gmlp_phase(const Params& p, LAS unsigned char* lds) {
  unsigned char* ws = p.ws;
  const bf16_t* GT = (const bf16_t*)(ws + WS_GT); const bf16_t* Ub = (const bf16_t*)(ws + WS_UB); const bf16_t* WSb = (const bf16_t*)(ws + WS_WS); bf16_t* CAT = (bf16_t*)(ws + WS_CAT);
  const int tid = opaque_tid(), lane = tid & 63, wave = tid >> 6, fr = lane & 15, G = lane >> 4;
  LAS unsigned char* Gs = lds; LAS float* mu = (LAS float*)(lds + 64 * VS_STRIDE); LAS float* rstd = mu + 128;
  for (int item = blockIdx.x; item < 2048; item += gridDim.x) {
    const int tb = item >> 3, grp = item & 7;
    __syncthreads();
#pragma unroll
    for (int i = 0; i < 2; ++i) { const int pc = tid + i * 512, d = pc >> 4, ch = pc & 15;
      *(LAS u32x4*)(Gs + d * VS_STRIDE + ch * 16) = *(const u32x4*)(GT + (size_t)((tb * 8 + grp) * 64 + d) * 128 + ch * 8); }
    __syncthreads();
    if (tid < 128) { float s = 0.f, s2 = 0.f;
      for (int d = 0; d < 64; ++d) { const float v = __uint_as_float((unsigned)(*(const LAS bf16_t*)(Gs + d * VS_STRIDE + tid * 2)) << 16); s += v; }
      const float mean = s * (1.0f / 64.0f);
      for (int d = 0; d < 64; ++d) { const float v = __uint_as_float((unsigned)(*(const LAS bf16_t*)(Gs + d * VS_STRIDE + tid * 2)) << 16) - mean; s2 += v * v; }
      mu[tid] = mean; rstd[tid] = rsqrtf(s2 * (1.0f / 64.0f) + 1e-6f); }
    __syncthreads();
#pragma unroll
    for (int i = 0; i < 8; ++i) { const int e = tid + i * 512, d = e >> 6, qp = e & 63;
      LAS unsigned* wp = (LAS unsigned*)(Gs + d * VS_STRIDE + qp * 4); const unsigned w = *wp;
      *wp = pk2((bf_lo(w) - mu[2 * qp]) * rstd[2 * qp], (bf_hi(w) - mu[2 * qp + 1]) * rstd[2 * qp + 1]); }
    __syncthreads();
    f32x4 acc[4];
#pragma unroll
    for (int dt = 0; dt < 4; ++dt) acc[dt] = (f32x4){0.f, 0.f, 0.f, 0.f};
    const int prow = 16 * wave + fr;
#pragma unroll
    for (int ks = 0; ks < 4; ++ks) {
      const bf16x8 wf = *(const bf16x8*)(WSb + (size_t)(grp * 128 + prow) * 128 + ks * 32 + 8 * G);
#pragma unroll
      for (int dt = 0; dt < 4; ++dt) { const bf16x8 xf = *(const LAS bf16x8*)(Gs + (16 * dt + fr) * VS_STRIDE + ks * 64 + G * 16);
        acc[dt] = __builtin_amdgcn_mfma_f32_16x16x32_bf16(xf, wf, acc[dt], 0, 0, 0); }
    }
    const float bias = p.gmlp_b_s[grp * 128 + prow]; const size_t t = (size_t)tb * 128 + prow;
#pragma unroll
    for (int dt = 0; dt < 4; ++dt) { const u32x2 uu = *(const u32x2*)(Ub + t * 512 + grp * 64 + 16 * dt + 4 * G);
      u32x2 w; w.x = pk2(bf_lo(uu.x) * (acc[dt][0] + bias), bf_hi(uu.x) * (acc[dt][1] + bias)); w.y = pk2(bf_lo(uu.y) * (acc[dt][2] + bias), bf_hi(uu.y) * (acc[dt][3] + bias));
      *(u32x2*)(CAT + t * DM + 512 + grp * 64 + 16 * dt + 4 * G) = w; }
  }
  __syncthreads();
}

__device__ __forceinline__ void bitonic_merge16_desc(float (&v)[16]) {
#pragma unroll
  for (int j = 8; j > 0; j >>= 1)
#pragma unroll
    for (int i = 0; i < 16; ++i) { const int l = i ^ j; if (l > i) { const float a = v[i], b = v[l]; v[i] = fmaxf(a, b); v[l] = fminf(a, b); } }
}
__device__ __forceinline__ void merge_top16(float (&a)[16], const float (&b)[16]) {
#pragma unroll
  for (int i = 0; i < 16; ++i) a[i] = fmaxf(a[i], b[15 - i]);
  bitonic_merge16_desc(a);
}
__device__ __forceinline__ float clr(float v, unsigned m) { return __uint_as_float(__float_as_uint(v) & ~m); }
__device__ __forceinline__ float cand(const float (&f0)[16], const float (&f1)[16], int a, int b) { return __uint_as_float((__float_as_uint(f0[a] + f1[b]) & ~0xffu) | (unsigned)(a * 16 + b)); }

__device__ __forceinline__ void ce_desc(float& a, float& b) { const float mx = fmaxf(a, b), mn = fminf(a, b); a = mx; b = mn; }
__device__ __forceinline__ void oe_sort16_desc(float (&v)[16]) {
  constexpr unsigned char N[63][2] = {{0,1}, {2,3}, {0,2}, {1,3}, {1,2}, {4,5}, {6,7}, {4,6}, {5,7}, {5,6}, {0,4}, {2,6}, {2,4}, {1,5}, {3,7}, {3,5}, {1,2}, {3,4}, {5,6}, {8,9}, {10,11}, {8,10}, {9,11}, {9,10}, {12,13}, {14,15}, {12,14}, {13,15}, {13,14}, {8,12}, {10,14}, {10,12}, {9,13}, {11,15}, {11,13}, {9,10}, {11,12}, {13,14}, {0,8}, {4,12}, {4,8}, {2,10}, {6,14}, {6,10}, {2,4}, {6,8}, {10,12}, {1,9}, {5,13}, {5,9}, {3,11}, {7,15}, {7,11}, {3,5}, {7,9}, {11,13}, {1,2}, {3,4}, {5,6}, {7,8}, {9,10}, {11,12}, {13,14}};
#pragma unroll
  for (int c = 0; c < 63; ++c) ce_desc(v[N[c][0]], v[N[c][1]]);
}
__device__ __forceinline__ float f16lo(unsigned w) { return (float)__builtin_bit_cast(_Float16, (unsigned short)(w & 0xffffu)); }
__device__ __forceinline__ float f16hi(unsigned w) { return (float)__builtin_bit_cast(_Float16, (unsigned short)(w >> 16)); }

__device__ __forceinline__ void topk_phase(const Params& p, LAS unsigned char* lds, int layer) {
  unsigned char* ws = p.ws;
  const unsigned short* SC = (const unsigned short*)(ws + WS_QP);
  unsigned short* IDX = (unsigned short*)(ws + WS_IDX); bf16_t* A1 = (bf16_t*)(ws + WS_GW); bf16_t* A2 = A1 + (size_t)NT * 128;
  const float* SD = (const float*)(ws + WS_SD) + layer * NEXP; const float* SU = (const float*)(ws + WS_SU) + layer * NEXP;
  const int tid = opaque_tid(), lane = tid & 63, wave = tid >> 6;
  LAS unsigned char* wl = lds + wave * 16384;
  const int srow = lane >> 4, sch = lane & 15;
  const int sw = lane & 15;
  const int nunits = NT / 8, ustride = gridDim.x * NWAVES;
  __syncthreads();
  u32x4 buf[16];
  int u = blockIdx.x * NWAVES + wave;
  if (u < nunits) {
#pragma unroll
    for (int i = 0; i < 16; ++i) { const int row = 4 * i + srow; buf[i] = *(const u32x4*)(SC + (size_t)(u * 8 + (row >> 3)) * 2048 + (row & 7) * 256 + sch * 8); }
  }
#pragma unroll 1
  for (; u < nunits; u += ustride) {
    const int t0 = u * 8;
    float s0[16], s1[16];
#pragma unroll
    for (int pp = 0; pp < 2; ++pp) {
#pragma unroll
      for (int i = 0; i < 16; ++i) { const int row = 4 * i + srow; *(LAS u32x4*)(wl + row * 256 + ((sch ^ (row & 15)) * 16)) = buf[i]; }
      { const int un = pp == 0 ? u : min(u + ustride, nunits - 1), pn = pp ^ 1;
#pragma unroll
        for (int i = 0; i < 16; ++i) { const int row = 4 * i + srow; buf[i] = *(const u32x4*)(SC + (size_t)(un * 8 + (row >> 3)) * 2048 + (row & 7) * 256 + pn * 128 + sch * 8); } }
      float top[16];
#pragma unroll
      for (int c = 0; c < 8; ++c) {
        const u32x4 w0 = *(const LAS u32x4*)(wl + lane * 256 + (((2 * c) ^ sw) * 16)), w1 = *(const LAS u32x4*)(wl + lane * 256 + (((2 * c + 1) ^ sw) * 16));
        float ch[16];
#pragma unroll
        for (int j = 0; j < 4; ++j) {
          ch[2 * j]         = __uint_as_float((w0[j] << 16) | (unsigned)(16 * c + 2 * j));
          ch[2 * j + 1]     = __uint_as_float((w0[j] & 0xffff0000u) | (unsigned)(16 * c + 2 * j + 1));
          ch[8 + 2 * j]     = __uint_as_float((w1[j] << 16) | (unsigned)(16 * c + 8 + 2 * j));
          ch[8 + 2 * j + 1] = __uint_as_float((w1[j] & 0xffff0000u) | (unsigned)(16 * c + 8 + 2 * j + 1)); }
        oe_sort16_desc(ch);
        if (c == 0) {
#pragma unroll
          for (int i = 0; i < 16; ++i) top[i] = ch[i];
        } else merge_top16(top, ch);
      }
#pragma unroll
      for (int i = 0; i < 16; ++i) { if (pp == 0) s0[i] = top[i]; else s1[i] = top[i]; }
    }
#pragma unroll
    for (int i = 0; i < 16; ++i) { *(LAS float*)(wl + lane * 256 + ((i ^ sw) * 4)) = s0[i]; *(LAS float*)(wl + lane * 256 + 64 + ((i ^ sw) * 4)) = s1[i]; }
    float f0[16], f1[16];
#pragma unroll
    for (int i = 0; i < 16; ++i) { f0[i] = f16hi(__float_as_uint(s0[i])); f1[i] = f16hi(__float_as_uint(s1[i])); }
    float top[16];
#pragma unroll
    for (int b = 0; b < 16; ++b) top[b] = cand(f0, f1, 0, b);
    { float l1[16] = {cand(f0, f1, 1, 0), cand(f0, f1, 1, 1), cand(f0, f1, 1, 2), cand(f0, f1, 1, 3), cand(f0, f1, 1, 4), cand(f0, f1, 1, 5), cand(f0, f1, 1, 6), cand(f0, f1, 1, 7),
                      cand(f0, f1, 2, 0), cand(f0, f1, 2, 1), cand(f0, f1, 2, 2), cand(f0, f1, 2, 3), cand(f0, f1, 2, 4), cand(f0, f1, 3, 0), cand(f0, f1, 3, 1), cand(f0, f1, 3, 2)};
      oe_sort16_desc(l1); merge_top16(top, l1); }
    { float l2[16] = {cand(f0, f1, 3, 3), cand(f0, f1, 4, 0), cand(f0, f1, 4, 1), cand(f0, f1, 4, 2), cand(f0, f1, 5, 0), cand(f0, f1, 5, 1), cand(f0, f1, 6, 0), cand(f0, f1, 6, 1),
                      cand(f0, f1, 7, 0), cand(f0, f1, 7, 1), cand(f0, f1, 8, 0), cand(f0, f1, 9, 0), cand(f0, f1, 10, 0), cand(f0, f1, 11, 0), cand(f0, f1, 12, 0), cand(f0, f1, 13, 0)};
      oe_sort16_desc(l2); merge_top16(top, l2); }
    { float x = cand(f0, f1, 14, 0), y = cand(f0, f1, 15, 0); ce_desc(x, y); top[15] = fmaxf(top[15], x); top[14] = fmaxf(top[14], y); }
    float mx = clr(top[0], 255u);
#pragma unroll
    for (int i = 1; i < 16; ++i) mx = fmaxf(mx, clr(top[i], 255u));
    float e[16]; float sum = 0.f;
#pragma unroll
    for (int i = 0; i < 16; ++i) { e[i] = __expf(clr(top[i], 255u) - mx); sum += e[i]; }
    const float inv = 1.0f / sum;
    unsigned ex[16];
#pragma unroll
    for (int i = 0; i < 16; ++i) { const unsigned code = __float_as_uint(top[i]) & 255u; const unsigned a = code >> 4, b = code & 15u;
      const unsigned e0 = __float_as_uint(*(const LAS float*)(wl + lane * 256 + ((a ^ sw) * 4))) & 127u, e1 = __float_as_uint(*(const LAS float*)(wl + lane * 256 + 64 + ((b ^ sw) * 4))) & 127u;
      ex[i] = e0 * 128u + e1; }
    const size_t ob = (size_t)(t0 + (lane >> 3)) * 128 + (lane & 7) * 16;
    u32x4 iw0, iw1; iw0.x = ex[0] | (ex[1] << 16); iw0.y = ex[2] | (ex[3] << 16); iw0.z = ex[4] | (ex[5] << 16); iw0.w = ex[6] | (ex[7] << 16);
    iw1.x = ex[8] | (ex[9] << 16); iw1.y = ex[10] | (ex[11] << 16); iw1.z = ex[12] | (ex[13] << 16); iw1.w = ex[14] | (ex[15] << 16);
    *(u32x4*)(IDX + ob) = iw0; *(u32x4*)(IDX + ob + 8) = iw1;
    float sdv[16], suv[16];
#pragma unroll
    for (int i = 0; i < 16; ++i) { sdv[i] = SD[ex[i]]; suv[i] = SU[ex[i]]; }
    u32x4 a1w0, a1w1, a2w0, a2w1;
#pragma unroll
    for (int j = 0; j < 4; ++j) { a1w0[j] = pk2(sdv[2 * j], sdv[2 * j + 1]); a1w1[j] = pk2(sdv[8 + 2 * j], sdv[8 + 2 * j + 1]);
      a2w0[j] = pk2(e[2 * j] * inv * suv[2 * j], e[2 * j + 1] * inv * suv[2 * j + 1]); a2w1[j] = pk2(e[8 + 2 * j] * inv * suv[8 + 2 * j], e[8 + 2 * j + 1] * inv * suv[8 + 2 * j + 1]); }
    *(u32x4*)(A1 + ob) = a1w0; *(u32x4*)(A1 + ob + 8) = a1w1; *(u32x4*)(A2 + ob) = a2w0; *(u32x4*)(A2 + ob + 8) = a2w1;
  }
  __syncthreads();
}

struct PeerIdx { int v[16]; };
__device__ __forceinline__ PeerIdx peer_load_idx(const unsigned short* IDX, int t, int r) {
  PeerIdx o; const int tt = t < NT ? t : NT - 1;
#pragma unroll
  for (int j = 0; j < 2; ++j) { const u32x4 q = *(const u32x4*)(IDX + (size_t)tt * 128 + r * 16 + 8 * j);
#pragma unroll
    for (int k = 0; k < 4; ++k) { o.v[8 * j + 2 * k] = (int)(q[k] & 0xffffu); o.v[8 * j + 2 * k + 1] = (int)(q[k] >> 16); } }
  return o;
}
struct PeerRows { u32x4 d[16]; };
__device__ __forceinline__ PeerRows peer_gather(const unsigned char* T, const PeerIdx& ix, unsigned laneoff) {
  PeerRows o;
#pragma unroll
  for (int i = 0; i < 16; ++i) o.d[i] = *(const u32x4*)(T + (((unsigned)ix.v[i] << 7) + laneoff));
  return o;
}
typedef int i32x8 __attribute__((ext_vector_type(8)));
struct PeerA { u32x4 v; int scale; };
__device__ __forceinline__ void peer_down_token(const PeerRows& R, const PeerA A, bf16_t* dst, bool diag, bool b0, bool b1) {
  float E[32];
  const f32x4 z = (f32x4){0.f, 0.f, 0.f, 0.f};
  const i32x8 a = (i32x8){(int)A.v[0], (int)A.v[1], (int)A.v[2], (int)A.v[3], 0, 0, 0, 0};
#pragma unroll
  for (int g = 0; g < 16; ++g) {
    const i32x8 b = (i32x8){(int)R.d[g][0], (int)R.d[g][1], (int)R.d[g][2], (int)R.d[g][3], 0, 0, 0, 0};
    const f32x4 d = __builtin_amdgcn_mfma_scale_f32_16x16x128_f8f6f4(a, b, z, 4  , 4  , 0, A.scale, 0, 0x7f7f7f7f);
    E[2 * g] = diag ? d[0] + d[1] : 0.f; E[2 * g + 1] = diag ? d[2] + d[3] : 0.f; }
  float Rr[8], S[4], T[2];
#pragma unroll
  for (int G = 0; G < 8; ++G)
    Rr[G] = swap32_sum(swap16_sum(E[2 * G], E[2 * G + 1]), swap16_sum(E[2 * (G + 8)], E[2 * (G + 8) + 1]));
#pragma unroll
  for (int g0 = 0; g0 < 2; ++g0)
#pragma unroll
    for (int g2 = 0; g2 < 2; ++g2) { const float lo = Rr[g0 + 4 * g2], hi = Rr[g0 + 2 + 4 * g2];
      S[g0 + 2 * g2] = (b0 ? hi : lo) + dppf<0xB1>(b0 ? lo : hi); }
#pragma unroll
  for (int g0 = 0; g0 < 2; ++g0) T[g0] = (b1 ? S[g0 + 2] : S[g0]) + dppf<0x4E>(b1 ? S[g0] : S[g0 + 2]);
  *(unsigned*)dst = pk2(T[0], T[1]);
}
__device__ __forceinline__ void peer_down_phase(const Params& p, int layer) {
  unsigned char* ws = p.ws;
  const int tid = opaque_tid(), lane = tid & 63, wave = tid >> 6, kg = lane >> 4, m = lane & 15, u = (lane >> 2) & 3, v = lane & 3;
  const int x = blockIdx.x & 7, rank = blockIdx.x >> 3, nslot = (gridDim.x >> 3) * NWAVES;
  if (rank >= (int)(gridDim.x >> 3)) return;
  const int sl = x & 3, te = ((x >> 2) + 1) * (NT / 2);
  const int q = 2 * u + (kg >> 1);
  const unsigned short* IDX = (const unsigned short*)(ws + WS_IDX);
  const unsigned char* TD = ws + WS_TD4 + (size_t)layer * NEXP * 512 + (size_t)sl * NEXP * 128; const unsigned laneoff = 16 * (4 * (kg & 1) + v);
  bf16_t* PART = (bf16_t*)(ws + WS_PART) + (size_t)sl * NT * 128 + 16 * (2 * u + (kg & 1)) + 8 * (kg >> 1) + 2 * v;
  const int blk = 8 * sl + 4 * (kg & 1) + (m >> 2);
  const unsigned char* HQl = ws + WS_HQ + (m & 1) * 512 + blk * 16; const unsigned char* HSl = ws + WS_HS + blk;
  const bool live = (kg >> 1) == ((m >> 1) & 1), diag = kg == v, b0 = (v & 1) != 0, b1 = (v & 2) != 0; const int sdec = 2 * (m & 1);
  int t = (x >> 2) * (NT / 2) + rank * NWAVES + wave;
  PeerIdx ia = peer_load_idx(IDX, t, q), ib = peer_load_idx(IDX, t + nslot, q);
  PeerRows ra = peer_gather(TD, ia, laneoff), rb;
  u32x4 ha, hb; unsigned sa, sb;
  { const int tc = t < te ? t : te - 1; ha = *(const u32x4*)(HQl + (size_t)tc * 1024); sa = HSl[(size_t)tc * 32]; }
#pragma unroll 1
  for (; t < te; t += 2 * nslot) {
    { const int tn = t + nslot, tc = tn < te ? tn : te - 1;
      rb = peer_gather(TD, ib, laneoff); hb = *(const u32x4*)(HQl + (size_t)tc * 1024); sb = HSl[(size_t)tc * 32];
      ia = peer_load_idx(IDX, t + 2 * nslot, q);
      PeerA A;
#pragma unroll
      for (int j = 0; j < 4; ++j) A.v[j] = live ? ha[j] : 0u;
      A.scale = (int)sa - sdec;
      peer_down_token(ra, A, PART + (size_t)t * 128, diag, b0, b1); }
    { const int tn = t + nslot; if (tn >= te) break;
      const int t2 = t + 2 * nslot, tc = t2 < te ? t2 : te - 1;
      ra = peer_gather(TD, ia, laneoff); ha = *(const u32x4*)(HQl + (size_t)tc * 1024); sa = HSl[(size_t)tc * 32];
      ib = peer_load_idx(IDX, t + 3 * nslot, q);
      PeerA A;
#pragma unroll
      for (int j = 0; j < 4; ++j) A.v[j] = live ? hb[j] : 0u;
      A.scale = (int)sb - sdec;
      peer_down_token(rb, A, PART + (size_t)tn * 128, diag, b0, b1); }
  }
}
__device__ __forceinline__ void peer_reduce_phase(const Params& p, int layer) {
  unsigned char* ws = p.ws;
  const int tid = opaque_tid();
  const bf16_t* PART = (const bf16_t*)(ws + WS_PART); const bf16_t* A1 = (const bf16_t*)(ws + WS_GW); const bf16_t* A2 = A1 + (size_t)NT * 128; bf16_t* CFo = (bf16_t*)(ws + WS_CF);
  constexpr int UB = 2;
  const size_t stride = (size_t)gridDim.x * NTHREADS, ngrp = (size_t)NT * 16;
#pragma unroll 1
  for (size_t i0 = (size_t)blockIdx.x * NTHREADS + tid; i0 < ngrp; i0 += UB * stride) {
    u32x4 pw[UB][4], a1[UB], a2[UB];
#pragma unroll
    for (int u = 0; u < UB; ++u) { const size_t i = min(i0 + u * stride, ngrp - 1);
#pragma unroll
      for (int x = 0; x < 4; ++x) pw[u][x] = *(const u32x4*)(PART + (size_t)x * NT * 128 + i * 8);
      a1[u] = *(const u32x4*)(A1 + i * 8); a2[u] = *(const u32x4*)(A2 + i * 8); }
#pragma unroll
    for (int u = 0; u < UB; ++u) { const size_t i = i0 + u * stride; if (i >= ngrp) break;
      float a[8];
#pragma unroll
      for (int j = 0; j < 8; ++j) a[j] = 0.f;
#pragma unroll
      for (int x = 0; x < 4; ++x)
#pragma unroll
        for (int j = 0; j < 4; ++j) { a[2 * j] += bf_lo(pw[u][x][j]); a[2 * j + 1] += bf_hi(pw[u][x][j]); }
      f32x2 cf[4];
#pragma unroll
      for (int j = 0; j < 4; ++j) cf[j] = (f32x2){bf_lo(a2[u][j]) * gelu_tanh(a[2 * j] * bf_lo(a1[u][j])), bf_hi(a2[u][j]) * gelu_tanh(a[2 * j + 1] * bf_hi(a1[u][j]))};
      float am = 0.f;
#pragma unroll
      for (int j = 0; j < 4; ++j) am = fmaxf(am, fmaxf(fabsf(cf[j].x), fabsf(cf[j].y)));
      am = fmaxf(am, dppf<0xB1>(am)); am = fmaxf(am, dppf<0x4E>(am));
      const int s0 = max((int)(__float_as_uint(am) >> 23), 64) - 1;
      const float inv0 = __uint_as_float((unsigned)(254 - s0) << 23);
      unsigned w0 = 0u, w1 = 0u, w2 = 0u;
#define PEER_Q_BYTE(b) { const f32x2 fs = cf[b] * inv0; \
      w0 = __builtin_amdgcn_cvt_scalef32_pk_fp4_f32(w0, fs.x, fs.y, 1.0f, b); \
      const f32x2 r1 = (fs - __builtin_amdgcn_cvt_scalef32_pk_f32_fp4(w0, 1.0f, b)) * 4.0f; \
      w1 = __builtin_amdgcn_cvt_scalef32_pk_fp4_f32(w1, r1.x, r1.y, 1.0f, b); \
      const f32x2 r2 = (r1 - __builtin_amdgcn_cvt_scalef32_pk_f32_fp4(w1, 1.0f, b)) * 4.0f; \
      w2 = __builtin_amdgcn_cvt_scalef32_pk_fp4_f32(w2, r2.x, r2.y, 1.0f, b); }
      PEER_Q_BYTE(0) PEER_Q_BYTE(1) PEER_Q_BYTE(2) PEER_Q_BYTE(3)
#undef PEER_Q_BYTE
      unsigned char* rec = (unsigned char*)CFo + (i >> 4) * 256; const int G = (int)(i & 15);
      unsigned* q = (unsigned*)(rec + (G >> 2) * 16 + (G & 3) * 4);
      q[0] = w0; q[16] = w1; q[32] = w2;
      if ((G & 3) == 0) rec[192 + (G >> 2)] = (unsigned char)s0;
      }
  }
}
typedef int i32x2 __attribute__((ext_vector_type(2)));
__device__ __forceinline__ void peer_up_stage(const PeerRows& R, LAS unsigned char* wl, unsigned W0) {
  asm volatile("" : "+v"(W0));
#pragma unroll
  for (int g = 0; g < 16; ++g) {
    const unsigned k = 16u * ((g >> 1) & 7) + 128u * g;
    *(LAS u32x2*)(wl + (W0 ^ k)) = (u32x2){R.d[g][0], R.d[g][1]};
    *(LAS u32x2*)(wl + (W0 ^ (k + 8u))) = (u32x2){R.d[g][2], R.d[g][3]}; }
}
__device__ __forceinline__ void peer_up_token(const PeerA A, LAS unsigned char* wl, unsigned R0, int lane, bf16_t* xr, u32x2 xw, f32x4 gg) {
  asm volatile("" : "+v"(R0));
  const f32x4 z = (f32x4){0.f, 0.f, 0.f, 0.f};
  const i32x8 a = (i32x8){(int)A.v[0], (int)A.v[1], (int)A.v[2], (int)A.v[3], 0, 0, 0, 0};
  float o16[16];
#pragma unroll
  for (int T = 0; T < 16; ++T) {
    const i32x2 b0 = __builtin_amdgcn_ds_read_tr4_b64_v2i32((LAS i32x2*)(wl + (R0 ^ (8u * T)))), b1 = __builtin_amdgcn_ds_read_tr4_b64_v2i32((LAS i32x2*)(wl + ((R0 ^ 128u ^ (8u * T)) + 2048)));
    const i32x8 b = (i32x8){b0[0], b0[1], b1[0], b1[1], 0, 0, 0, 0};
    const f32x4 d = __builtin_amdgcn_mfma_scale_f32_16x16x128_f8f6f4(a, b, z, 4, 4, 0, A.scale, 0, 0x7f7f7f7f);
    o16[T] = (d[0] + d[1]) + d[2];
    if ((T & 1) == 1) __builtin_amdgcn_sched_barrier(0); }
#pragma unroll
  for (int T = 0; T < 16; ++T) *(LAS float*)(wl + T * 256 + lane * 4) = o16[T];
  const f32x4 v = *(const LAS f32x4*)(wl + (lane >> 2) * 256 + (lane & 3) * 16);
  u32x2 w; w.x = pk2(bf_lo(xw.x) + gg[0] * v[0], bf_hi(xw.x) + gg[1] * v[1]); w.y = pk2(bf_lo(xw.y) + gg[2] * v[2], bf_hi(xw.y) + gg[3] * v[3]);
  *(u32x2*)xr = w;
}
struct PeerARaw { u32x4 v; unsigned sc; };
__device__ __forceinline__ PeerARaw peer_load_a(const unsigned char* CFQ, int t, int aoff) { PeerARaw o; const unsigned char* rec = CFQ + (size_t)t * 256; o.v = *(const u32x4*)(rec + aoff); o.sc = *(const unsigned*)(rec + 192); return o; }
__device__ __forceinline__ PeerA peer_make_a(const PeerARaw& q, int st, int kg, bool live) {
  PeerA o;
#pragma unroll
  for (int j = 0; j < 4; ++j) o.v[j] = live ? q.v[j] : 0u;
  o.scale = (int)((q.sc >> (8 * kg)) & 255u) - 2 * st;
  return o;
}
__device__ __forceinline__ void peer_up_phase(const Params& p, LAS unsigned char* lds, int layer) {
  unsigned char* ws = p.ws;
  const int tid = opaque_tid(), lane = tid & 63, wave = tid >> 6, r = lane >> 3, c = lane & 7, n = lane & 15, kg = lane >> 4;
  const int x = blockIdx.x & 7, rank = blockIdx.x >> 3, nslot = (gridDim.x >> 3) * NWAVES;
  if (rank >= (int)(gridDim.x >> 3)) return;
  const int sl = x & 3, te = ((x >> 2) + 1) * (NT / 2);
  LAS unsigned char* wl = lds + wave * 16384;
  const unsigned W0 = (unsigned)(16 * r * 128 + 128 * (r & 1) + 16 * c + 8 * ((r >> 1) & 1));
  const unsigned R0 = (unsigned)((32 * kg + n) * 128 + 16 * ((n >> 1) & 7) + 8 * (kg & 1));
  const unsigned short* IDX = (const unsigned short*)(ws + WS_IDX); const unsigned char* CFQ = ws + WS_CF; const float* MOD = (const float*)(ws + WS_MOD);
  const unsigned char* TU = ws + WS_TU4 + (size_t)layer * NEXP * 512 + (size_t)sl * NEXP * 128; const unsigned laneoff = 16 * c;
  const int col = 256 * sl + 4 * lane;
  bf16_t* XR = (bf16_t*)(ws + WS_XR) + col;
  const float* g2b = MOD + (size_t)(layer == 0 ? 0 : 3) * 6144 + 5 * DM + col;
  const int st = lane & 15; const bool live = st < 3; const int aoff = ((live ? st : 0) * 4 + kg) * 16;
  int t = (x >> 2) * (NT / 2) + rank * NWAVES + wave;
  PeerIdx ia = peer_load_idx(IDX, t, r), ib = peer_load_idx(IDX, t + nslot, r);
  PeerRows ra = peer_gather(TU, ia, laneoff), rb = peer_gather(TU, ib, laneoff);
  ia = peer_load_idx(IDX, t + 2 * nslot, r); ib = peer_load_idx(IDX, t + 3 * nslot, r);
  PeerARaw qa = peer_load_a(CFQ, min(t, te - 1), aoff), qb;
  u32x2 xa = *(const u32x2*)(XR + (size_t)min(t, te - 1) * DM), xb;
  const f32x4 gg = *(const f32x4*)(g2b + (size_t)(x >> 2) * 6144);
  __syncthreads();
#pragma unroll 1
  for (; t < te; t += 2 * nslot) {
    { const int tc = min(t + nslot, te - 1);
      peer_up_stage(ra, wl, W0); __builtin_amdgcn_sched_barrier(0);
      ra = peer_gather(TU, ia, laneoff); ia = peer_load_idx(IDX, t + 4 * nslot, r); __builtin_amdgcn_sched_barrier(0);
      qb = peer_load_a(CFQ, tc, aoff); xb = *(const u32x2*)(XR + (size_t)tc * DM);
      peer_up_token(peer_make_a(qa, st, kg, live), wl, R0, lane, XR + (size_t)t * DM, xa, gg); }
    { const int tn = t + nslot; if (tn >= te) break;
      const int tc = min(t + 2 * nslot, te - 1);
      peer_up_stage(rb, wl, W0); __builtin_amdgcn_sched_barrier(0);
      rb = peer_gather(TU, ib, laneoff); ib = peer_load_idx(IDX, t + 5 * nslot, r); __builtin_amdgcn_sched_barrier(0);
      qa = peer_load_a(CFQ, tc, aoff); xa = *(const u32x2*)(XR + (size_t)tc * DM);
      peer_up_token(peer_make_a(qb, st, kg, live), wl, R0, lane, XR + (size_t)tn * DM, xb, gg); }
  }
}
__device__ __forceinline__ void final_norm_phase(const Params& p) {
  const int tid = opaque_tid(), lane = tid & 63, wave = tid >> 6;
  const int gw = blockIdx.x * NWAVES + wave, NGW = gridDim.x * NWAVES;
  constexpr int RB = 4;
  f32x4 FG[4];
#pragma unroll
  for (int j = 0; j < 4; ++j) FG[j] = ((const f32x4*)p.final_g)[lane + 64 * j];
#pragma unroll 1
  for (int r0 = gw; r0 < NT; r0 += RB * NGW) {
    f32x4 v[RB][4];
#pragma unroll
    for (int q = 0; q < RB; ++q) { const int r = min(r0 + q * NGW, NT - 1); const u32x2* xr = (const u32x2*)((const bf16_t*)(p.ws + WS_XR) + (size_t)r * DM) + lane;
#pragma unroll
      for (int j = 0; j < 4; ++j) { const u32x2 w = xr[64 * j]; v[q][j] = (f32x4){bf_lo(w.x), bf_hi(w.x), bf_lo(w.y), bf_hi(w.y)}; } }
#pragma unroll
    for (int q = 0; q < RB; ++q) { const int r = r0 + q * NGW; if (r >= NT) break;
      float ss = 0.f;
#pragma unroll
      for (int j = 0; j < 4; ++j) ss += (v[q][j][0] * v[q][j][0] + v[q][j][1] * v[q][j][1]) + (v[q][j][2] * v[q][j][2] + v[q][j][3] * v[q][j][3]);
      const float rr = rsqrtf(wave_sum(ss) * (1.0f / DM) + 1e-6f);
      f32x4* xo = (f32x4*)(p.out + (size_t)r * DM) + lane;
#pragma unroll
      for (int j = 0; j < 4; ++j) __builtin_nontemporal_store(v[q][j] * rr * FG[j], xo + 64 * j);
    }
  }
}

__device__ __forceinline__ void pool_fused_phase(const Params& p, LAS unsigned char* lds) {
  unsigned char* ws = p.ws;
  const int tid = opaque_tid(), lane = tid & 63, wave = tid >> 6;
  const float* MOD = (const float*)(ws + WS_MOD); bf16_t* PO = (bf16_t*)(ws + WS_CAT);
  const float* ng = p.norm1_g + DM;
  u32x2 pre[6][4];
  auto fetch_rows = [&](int tile) {
    const int t0 = tile * 32, s0 = t0 & (SEQL - 1), b = t0 >> 14;
#pragma unroll
    for (int q = 0; q < 6; ++q) { const int pos = min(max(s0 - 8 + wave + q * NWAVES, 0), SEQL - 1); const u32x2* xr = (const u32x2*)((const bf16_t*)(ws + WS_XR) + (size_t)(b * SEQL + pos) * DM) + lane;
#pragma unroll
      for (int e = 0; e < 4; ++e) pre[q][e] = xr[64 * e]; }
  };
  if (xcd_item(0, NT / 32) < NT / 32) fetch_rows(xcd_item(0, NT / 32));
#pragma unroll 1
  for (int rnd = 0, tile = xcd_item(0, NT / 32); tile < NT / 32; tile = xcd_item(++rnd, NT / 32)) {
    const int t0 = tile * 32, s0 = t0 & (SEQL - 1), b = t0 >> 14;
    const float* sh = MOD + (size_t)(3 + b) * 6144; const float* sc = sh + DM;
    f32x4 PA[4], PB[4];
#pragma unroll
    for (int e = 0; e < 4; ++e) { PA[e] = ((const f32x4*)ng)[lane + 64 * e] * (((const f32x4*)sc)[lane + 64 * e] + 1.0f); PB[e] = ((const f32x4*)sh)[lane + 64 * e]; }
    __syncthreads();
#pragma unroll
    for (int q = 0; q < 6; ++q) { const int j = wave + q * NWAVES, pos = s0 - 8 + j;
      if (pos >= 0 && pos < SEQL) {
        f32x4 v[4]; float ss = 0.f;
#pragma unroll
        for (int e = 0; e < 4; ++e) { const u32x2 w = pre[q][e]; v[e] = (f32x4){bf_lo(w.x), bf_hi(w.x), bf_lo(w.y), bf_hi(w.y)}; ss += (v[e][0] * v[e][0] + v[e][1] * v[e][1]) + (v[e][2] * v[e][2] + v[e][3] * v[e][3]); }
        const float r = rsqrtf(wave_sum(ss) * (1.0f / DM) + 1e-6f);
        LAS u32x2* o8 = (LAS u32x2*)(lds + j * 2048) + lane;
#pragma unroll
        for (int e = 0; e < 4; ++e) { const f32x4 y = (v[e] * r) * PA[e] + PB[e]; u32x2 w; w.x = pk2(y[0], y[1]); w.y = pk2(y[2], y[3]); o8[64 * e] = w; }
      }
    }
    __syncthreads();
    if (xcd_item(rnd + 1, NT / 32) < NT / 32) fetch_rows(xcd_item(rnd + 1, NT / 32));
    { const int grp = wave & 3, ch = grp * 32 + (lane & 31);
      auto pool_tok = [&](auto HWc, int tok) {
        constexpr int HW = decltype(HWc)::value;
        const int sq = s0 + tok;
        u32x4 w[2 * HW];
#pragma unroll
        for (int q = 0; q < 2 * HW; ++q) w[q] = *(const LAS u32x4*)(lds + (tok + 8 - HW + q) * 2048 + ch * 16);
        const u32x4 c = *(const LAS u32x4*)(lds + (tok + 8) * 2048 + ch * 16);
        float sum[8]; float cnt = 0.f;
#pragma unroll
        for (int j = 0; j < 8; ++j) sum[j] = 0.f;
#pragma unroll
        for (int q = 0; q < 2 * HW; ++q) { const int pos = sq - HW + q; const bool ok = (pos >= 0 && pos < SEQL); cnt += ok ? 1.0f : 0.0f;
#pragma unroll
          for (int j = 0; j < 4; ++j) { sum[2 * j] += ok ? bf_lo(w[q][j]) : 0.0f; sum[2 * j + 1] += ok ? bf_hi(w[q][j]) : 0.0f; } }
        const float inv = 1.0f / cnt; u32x4 o;
#pragma unroll
        for (int j = 0; j < 4; ++j) o[j] = pk2(sum[2 * j] * inv - bf_lo(c[j]), sum[2 * j + 1] * inv - bf_hi(c[j]));
        *(u32x4*)(PO + (size_t)(t0 + tok) * DM + ch * 8) = o;
      };
#pragma unroll 1
      for (int i = 0; i < 8; ++i) {
        const int tok = (wave >> 2) * 16 + 2 * i + (lane >> 5);
        if (grp == 0) pool_tok(std::integral_constant<int, 1>{}, tok);
        else if (grp == 1) pool_tok(std::integral_constant<int, 2>{}, tok);
        else if (grp == 2) pool_tok(std::integral_constant<int, 4>{}, tok);
        else pool_tok(std::integral_constant<int, 8>{}, tok);
      }
    }
  }
  __syncthreads();
}

typedef const __attribute__((address_space(4))) Params* ParamsK;
__device__ __forceinline__ Params load_params() {
#if defined(__HIP_DEVICE_COMPILE__)
  ParamsK k = (ParamsK)__builtin_amdgcn_kernarg_segment_ptr(); asm volatile("" : "+s"(k)); return *k;
#else
  return Params{};
#endif
}
#define XBAR() do { XcdBarrier xb_; xb_.bar = (unsigned*)(load_params().ws + WS_BAR); xb_.x = xb_xcc_id(); xb_.st = (volatile LAS unsigned*)(lds + 131072); xcd_barrier(xb_); } while (0)

__global__ void __launch_bounds__(NTHREADS, 2) fwd_megakernel(Params p_arg) {
  extern __shared__ __attribute__((aligned(16))) unsigned char lds_raw[];
  LAS unsigned char* lds = (LAS unsigned char*)lds_raw;
  cg::grid_group grid = cg::this_grid();
  { volatile LAS unsigned* bst = (volatile LAS unsigned*)(lds + 131072);
    if (threadIdx.x < 4) bst[threadIdx.x] = 0u;
    if ((threadIdx.x & 63) == 0) *(volatile LAS unsigned*)(size_t)(LDS_WAVETAB + 4 * __builtin_amdgcn_s_getreg((5 << 11) | 4)) = threadIdx.x >> 6;
    __syncthreads();
    (void)xcd_barrier_post((unsigned*)(load_params().ws + WS_BAR), bst); }

  { const Params p = load_params(); phase_prep(p, lds); }
  if (p_arg.out == nullptr) grid.sync();
  XBAR();
  { const Params p = load_params(); unsigned char* ws = p.ws; const float* MOD = (const float*)(ws + WS_MOD); bf16_t* H = (bf16_t*)(ws + WS_H);
    const int tid = opaque_tid(), lane = tid & 63, wave = tid >> 6, gw = blockIdx.x * NWAVES + wave, NGW = gridDim.x * NWAVES;
    constexpr int RB = 4;
#pragma unroll 1
    for (int cls = 0; cls < 3; ++cls) {
      const int rbeg = cls == 0 ? 0 : (cls == 1 ? SEQL : NT), rend = cls == 0 ? SEQL : (cls == 1 ? NT : NTALL);
      const float* m = MOD + (size_t)cls * 6144;
      f32x4 A[4], B[4];
#pragma unroll
      for (int j = 0; j < 4; ++j) { A[j] = ((const f32x4*)p.norm1_g)[lane + 64 * j] * (((const f32x4*)(m + DM))[lane + 64 * j] + 1.0f); B[j] = ((const f32x4*)m)[lane + 64 * j]; }
#pragma unroll 1
      for (int r0 = rbeg + gw; r0 < rend; r0 += RB * NGW) {
        f32x4 v[RB][4];
#pragma unroll
        for (int q = 0; q < RB; ++q) { const int r = min(r0 + q * NGW, rend - 1); const f32x4* xr = (const f32x4*)(r < NT ? p.x + (size_t)r * DM : p.ctx + (size_t)(r - NT) * DM) + lane;
#pragma unroll
          for (int j = 0; j < 4; ++j) v[q][j] = xr[64 * j]; }
#pragma unroll
        for (int q = 0; q < RB; ++q) { const int r = r0 + q * NGW; if (r >= rend) break;
          float ss = 0.f;
#pragma unroll
          for (int j = 0; j < 4; ++j) ss += (v[q][j][0] * v[q][j][0] + v[q][j][1] * v[q][j][1]) + (v[q][j][2] * v[q][j][2] + v[q][j][3] * v[q][j][3]);
          const float rr = rsqrtf(wave_sum(ss) * (1.0f / DM) + 1e-6f);
          u32x2* o8 = (u32x2*)(H + (size_t)r * DM) + lane;
#pragma unroll
          for (int j = 0; j < 4; ++j) { const f32x4 y = (v[q][j] * rr) * A[j] + B[j]; u32x2 w; w.x = pk2(y[0], y[1]); w.y = pk2(y[2], y[3]); o8[64 * j] = w; }
        }
      }
    } }
  XBAR();
  { const Params p = load_params(); unsigned char* ws = p.ws;
    pg8::Gemm g{(const bf16_t*)(ws + WS_H), (const bf16_t*)(ws + WS_WIN), DM, DM, 0}; pg8::OrderG1 S; S.so.init(NT, INW, gridDim.x, blockIdx.x);
    EpiG1 E{(bf16_t*)(ws + WS_QB), (bf16_t*)(ws + WS_KB), (bf16_t*)(ws + WS_VT), (bf16_t*)(ws + WS_KC), (bf16_t*)(ws + WS_VCT), (bf16_t*)(ws + WS_UB), (bf16_t*)(ws + WS_GT), (const float*)(ws + WS_ROPE)};
    pg8::gemm_phase(lds, g, S, E);
    { const int G = gridDim.x, nunits = 898, maxu = (nunits + G - 1) / G, nfull = nunits - (maxu - 1) * G;
      const int nslack = (nfull == G) ? 0 : G - nfull; const int tid2 = opaque_tid();
      if (nslack == 0) convert_tables(p, 1, blockIdx.x * NWAVES + (tid2 >> 6), G * NWAVES, tid2 & 63);
      else if ((int)blockIdx.x >= nfull) convert_tables(p, 1, ((int)blockIdx.x - nfull) * NWAVES + (tid2 >> 6), nslack * NWAVES, tid2 & 63); } }
  XBAR();
  { const Params p = load_params(); attn_phase(p, lds); }
  { const Params p = load_params(); gmlp_phase(p, lds); }
  XBAR();
  { const Params p = load_params(); unsigned char* ws = p.ws;
    pg8::Gemm g{(const bf16_t*)(ws + WS_CAT), (const bf16_t*)(ws + WS_WOUT), DM, DM, 0}; pg8::StaticOrder S; S.init(NT, DM, gridDim.x, blockIdx.x);
    EpiBf16 E{(bf16_t*)(ws + WS_Y), DM};
    pg8::gemm_phase(lds, g, S, E); }
  XBAR();
#pragma unroll 1
  for (int layer = 0; layer < 2; ++layer) {
    { const Params p = load_params(); resid_norm_phase(p, layer); }
    XBAR();
    { const Params p = load_params(); unsigned char* ws = p.ws;
      pg8::Gemm g{(const bf16_t*)(ws + WS_H), (const bf16_t*)(ws + WS_WQ) + (size_t)layer * 2048 * DM, DM, DM, 0}; pg8::StaticOrder S; S.init(NT, 2048, gridDim.x, blockIdx.x);
      EpiF16 E{(unsigned short*)(ws + WS_QP), 2048};
      pg8::gemm_phase(lds, g, S, E); }
    XBAR();
    { const Params p = load_params(); topk_phase(p, lds, layer); }
    XBAR();
    { const Params p = load_params(); peer_down_phase(p, layer); }
    XBAR();
    { const Params p = load_params(); peer_reduce_phase(p, layer); }
    XBAR();
    { const Params p = load_params(); peer_up_phase(p, lds, layer); }
    XBAR();
    if (layer == 0) {
      { const Params p = load_params(); pool_fused_phase(p, lds); }
      XBAR();
      { const Params p = load_params(); unsigned char* ws = p.ws;
        pg8::Gemm g{(const bf16_t*)(ws + WS_CAT), (const bf16_t*)(ws + WS_WPOOL), DM, 256, 256}; pg8::StaticOrder S; S.init(NT, DM, gridDim.x, blockIdx.x);
        EpiBf16 E{(bf16_t*)(ws + WS_Y), DM};
        pg8::gemm_phase(lds, g, S, E); }
      XBAR();
    } else {
      { const Params p = load_params(); final_norm_phase(p); }
    }
  }
}

extern "C" void kernel_launch(void* const* d_in, const int* in_sizes, int n_in, void* d_out, int out_size, void* d_ws, size_t ws_size, hipStream_t stream) {
  static int grid_blocks = 0;
  if (grid_blocks == 0) {
    if (n_in != 20 || ws_size < WS_END || out_size != NT * DM) { fprintf(stderr, "kernel_launch: unexpected shapes (n_in %d, ws %zu < %zu, out %d)\n", n_in, ws_size, (size_t)WS_END, out_size); grid_blocks = -1; return; }
    int dev = 0, cus = 0, per_cu = 0;
    (void)hipGetDevice(&dev);
    (void)hipDeviceGetAttribute(&cus, hipDeviceAttributeMultiprocessorCount, dev);
    if (hipFuncSetAttribute((const void*)fwd_megakernel, hipFuncAttributeMaxDynamicSharedMemorySize, LDS_BYTES) != hipSuccess) { fprintf(stderr, "kernel_launch: hipFuncSetAttribute failed\n"); grid_blocks = -1; return; }
    if (hipOccupancyMaxActiveBlocksPerMultiprocessor(&per_cu, (const void*)fwd_megakernel, NTHREADS, LDS_BYTES) != hipSuccess || per_cu < 1) { fprintf(stderr, "kernel_launch: occupancy query says %d blocks per CU\n", per_cu); grid_blocks = -1; return; }
    grid_blocks = cus;
  }
  if (grid_blocks < 0) return;
  Params p{};
  p.x = (const float*)d_in[0]; p.c = (const float*)d_in[1]; p.ctx = (const float*)d_in[2]; p.c_ctx = (const float*)d_in[3]; p.mod_w = (const float*)d_in[4]; p.mod_b = (const float*)d_in[5];
  p.norm1_g = (const float*)d_in[6]; p.norm2_g = (const float*)d_in[7]; p.attn_in_w = (const float*)d_in[8]; p.attn_out_w = (const float*)d_in[9]; p.attn_sink = (const float*)d_in[10];
  p.gmlp_w_s = (const float*)d_in[11]; p.gmlp_b_s = (const float*)d_in[12]; p.pool_w = (const float*)d_in[13]; p.pool_scale = (const float*)d_in[14]; p.peer_w_q = (const float*)d_in[15];
  p.peer_sub_keys = (const float*)d_in[16]; p.peer_down = (const float*)d_in[17]; p.peer_up = (const float*)d_in[18]; p.final_g = (const float*)d_in[19];
  p.out = (float*)d_out; p.ws = (unsigned char*)d_ws;
  (void)hipMemsetAsync((char*)d_ws + WS_BAR, 0, XCD_BAR_WORDS * 4, stream);
  void* args[] = {&p};
  hipError_t e = hipLaunchCooperativeKernel((void*)fwd_megakernel, dim3(grid_blocks), dim3(NTHREADS), args, LDS_BYTES, stream);
  if (e != hipSuccess) fprintf(stderr, "cooperative launch failed: %s (grid %d)\n", hipGetErrorString(e), grid_blocks);
}
```

```cpp
#include <hip/hip_runtime.h>
#include <hip/hip_cooperative_groups.h>
#include <cstdio>
#include <type_traits>
namespace cg = cooperative_groups;

#define LAS __attribute__((address_space(3)))
typedef unsigned short bf16_t;
typedef short bf16x8 __attribute__((ext_vector_type(8)));
typedef __bf16 bf16v2 __attribute__((ext_vector_type(2)));
typedef float f32x4 __attribute__((ext_vector_type(4)));
typedef float f32x2 __attribute__((ext_vector_type(2)));
typedef unsigned u32x4 __attribute__((ext_vector_type(4)));
typedef unsigned u32x2 __attribute__((ext_vector_type(2)));

constexpr int DM = 1024, NB = 2, SEQL = 16384, NT = NB * SEQL, CTXL = 256, NTC = NB * CTXL, NTALL = NT + NTC;
constexpr int INW = 1792, NEXP = 16384;
constexpr int NTHREADS = 512, NWAVES = 8;
constexpr int LDS_BYTES = 135168;

constexpr size_t WS_BAR   = 0;
constexpr size_t WS_XCNT  = 16384;
constexpr size_t XCNT_BYTES = (size_t)2 * 128 * 64;
constexpr size_t WS_MOD   = WS_XCNT + XCNT_BYTES;
constexpr size_t WS_ROPE  = WS_MOD + 131072;
constexpr size_t WS_WIN   = WS_ROPE + 32768;
constexpr size_t WS_WOUT  = WS_WIN + (size_t)INW * DM * 2;
constexpr size_t WS_WQ    = WS_WOUT + (size_t)DM * DM * 2;
constexpr size_t WS_WPOOL = WS_WQ + (size_t)2 * 2048 * DM * 2;
constexpr size_t WS_SK    = WS_WPOOL + (size_t)1024 * 256 * 2;
constexpr size_t WS_WS    = WS_SK + (size_t)2 * 2 * 128 * 128 * 2;
constexpr size_t WS_TD4   = WS_WS + (size_t)8 * 128 * 128 * 2;
constexpr size_t WS_TU4   = WS_TD4 + (size_t)2 * NEXP * 512;
constexpr size_t WS_SD    = WS_TU4 + (size_t)2 * NEXP * 512;
constexpr size_t WS_SU    = WS_SD + (size_t)2 * NEXP * 4;
constexpr size_t WS_H     = WS_SU + (size_t)2 * NEXP * 4;
constexpr size_t WS_R1    = WS_H + (size_t)NTALL * DM * 2;
constexpr size_t WS_CAT   = WS_R1;
constexpr size_t WS_QB    = WS_CAT + (size_t)NT * DM * 2;
constexpr size_t WS_KB    = WS_QB + (size_t)NT * 512 * 2;
constexpr size_t WS_VT    = WS_KB + (size_t)NT * 128 * 2;
constexpr size_t WS_KC    = WS_VT + (size_t)NT * 128 * 2;
constexpr size_t WS_VCT   = WS_KC + (size_t)NTC * 128 * 2;
constexpr size_t WS_UB    = WS_VCT + (size_t)NTC * 128 * 2;
constexpr size_t WS_GT    = WS_UB + (size_t)NT * 512 * 2;
constexpr size_t WS_Y     = WS_QB;
constexpr size_t WS_QP    = WS_QB;
constexpr size_t WS_R1END = WS_QP + (size_t)NT * 2048 * 2;
constexpr size_t WS_IDX   = WS_R1END;
constexpr size_t WS_GW    = WS_IDX + (size_t)NT * 128 * 4;
constexpr size_t WS_PART  = WS_QP;
constexpr size_t WS_CF    = WS_GW + (size_t)NT * 128 * 4;
constexpr size_t WS_XR    = WS_CF + (size_t)NT * 128 * 4;
constexpr size_t WS_HQ    = WS_XR + (size_t)NT * DM * 2;
constexpr size_t WS_HS    = WS_HQ + (size_t)NT * 1024;
constexpr size_t WS_XSLOT = WS_HS + (size_t)NT * 32;
constexpr size_t WS_END   = WS_XSLOT + (size_t)2 * 128 * 256 * 4 * 4;
static_assert(WS_GT + (size_t)NT * 512 * 2 <= WS_R1END, "layout");
static_assert(NT / 2 == SEQL, "the PEER passes split the tokens in two halves and take one half = one batch");

struct Params {
  const float *x, *c, *ctx, *c_ctx, *mod_w, *mod_b, *norm1_g, *norm2_g, *attn_in_w, *attn_out_w, *attn_sink, *gmlp_w_s, *gmlp_b_s,
      *pool_w, *pool_scale, *peer_w_q, *peer_sub_keys, *peer_down, *peer_up, *final_g;
  float* out; unsigned char* ws;
};

typedef const __attribute__((address_space(4))) Params* ParamsK;
__device__ __forceinline__ Params load_params() {
#if defined(__HIP_DEVICE_COMPILE__)
  ParamsK k = (ParamsK)__builtin_amdgcn_kernarg_segment_ptr(); asm volatile("" : "+s"(k)); return *k;
#else
  return Params{};
#endif
}

__device__ __forceinline__ unsigned pk2(float lo, float hi) { unsigned r; asm volatile("v_cvt_pk_bf16_f32 %0, %1, %2" : "=v"(r) : "v"(lo), "v"(hi)); return r; }
__device__ __forceinline__ float bf_lo(unsigned w) { return __uint_as_float(w << 16); }
__device__ __forceinline__ float bf_hi(unsigned w) { return __uint_as_float(w & 0xffff0000u); }
template <int CTRL> __device__ __forceinline__ float dppf(float v) { return __builtin_bit_cast(float, __builtin_amdgcn_update_dpp(0, __builtin_bit_cast(int, v), CTRL, 0xf, 0xf, true)); }
constexpr unsigned LDS_WAVETAB = 131072 + 256;
__device__ __forceinline__ int opaque_tid() {
  const unsigned hw = __builtin_amdgcn_s_getreg((5 << 11) | 4);
  const unsigned w = *(volatile LAS unsigned*)(size_t)(LDS_WAVETAB + 4 * hw);
  unsigned z = 0u; asm volatile("" : "+v"(z));
  int t = (int)((w << 6) | __builtin_amdgcn_mbcnt_hi(~0u, __builtin_amdgcn_mbcnt_lo(~0u, z)));
  asm volatile("" : "+v"(t)); return t; }
__device__ __forceinline__ float swap16_sum(float x, float y) {
  const auto s = __builtin_amdgcn_permlane16_swap(__float_as_uint(x), __float_as_uint(y), false, false);
  const unsigned r0 = s[0], r1 = s[1];
  return __uint_as_float(r0) + __uint_as_float(r1);
}
__device__ __forceinline__ float swap32_sum(float x, float y) {
  const auto s = __builtin_amdgcn_permlane32_swap(__float_as_uint(x), __float_as_uint(y), false, false);
  const unsigned r0 = s[0], r1 = s[1];
  return __uint_as_float(r0) + __uint_as_float(r1);
}
__device__ __forceinline__ float wave_sum(float v) {
  v += dppf<0xB1>(v); v += dppf<0x4E>(v); v += dppf<0x141>(v); v += dppf<0x128>(v);
  v = swap16_sum(v, v); return swap32_sum(v, v);
}
__device__ __forceinline__ float xor16_max(float x) { const auto s = __builtin_amdgcn_permlane16_swap(__float_as_uint(x), __float_as_uint(x), false, false); const unsigned r0 = s[0], r1 = s[1]; return fmaxf(__uint_as_float(r0), __uint_as_float(r1)); }
__device__ __forceinline__ float xor32_max(float x) { const auto s = __builtin_amdgcn_permlane32_swap(__float_as_uint(x), __float_as_uint(x), false, false); const unsigned r0 = s[0], r1 = s[1]; return fmaxf(__uint_as_float(r0), __uint_as_float(r1)); }
__device__ __forceinline__ float wave_max(float v) {
  v = fmaxf(v, dppf<0xB1>(v)); v = fmaxf(v, dppf<0x4E>(v)); v = fmaxf(v, dppf<0x141>(v)); v = fmaxf(v, dppf<0x128>(v));
  return xor32_max(xor16_max(v));
}
__device__ __forceinline__ float gelu_tanh(float x) {
  constexpr float C1 = -1.5957691216057308f * 1.4426950408889634f, C2 = C1 * 0.044715f;
  return x * __builtin_amdgcn_rcpf(1.0f + __builtin_amdgcn_exp2f(x * (C1 + C2 * (x * x))));
}
__device__ __forceinline__ f32x2 gelu_tanh2(const f32x2 x) {
  constexpr float C1 = -1.5957691216057308f * 1.4426950408889634f, C2 = C1 * 0.044715f;
  const f32x2 a = x * ((x * x) * C2 + C1);
  const f32x2 d = (f32x2){__builtin_amdgcn_exp2f(a.x), __builtin_amdgcn_exp2f(a.y)} + 1.0f;
  return x * (f32x2){__builtin_amdgcn_rcpf(d.x), __builtin_amdgcn_rcpf(d.y)};
}
__device__ __forceinline__ float silu(float x) { return x * __builtin_amdgcn_rcpf(1.0f + __expf(-x)); }


#define XB_TMO      128
#define XB_XCNT(j)  (256  + 64 * (j))
#define XB_XSUB(j)  (1280 + 64 * (j))
#define XB_XGEN(j)  (2304 + 64 * (j))
#define XB_TOP      3328
#define XB_TOPGEN   3392
#define XCD_BAR_WORDS 3456
#define XB_SPIN_CAP (1u << 18)
__device__ __forceinline__ unsigned xb_ld(unsigned* p)              { return __hip_atomic_load(p, __ATOMIC_RELAXED, __HIP_MEMORY_SCOPE_AGENT); }
__device__ __forceinline__ unsigned xb_add(unsigned* p, unsigned v) { return __hip_atomic_fetch_add(p, v, __ATOMIC_RELAXED, __HIP_MEMORY_SCOPE_AGENT); }
__device__ __forceinline__ unsigned xb_xcc_id() { return (unsigned)__builtin_amdgcn_s_getreg((3 << 11) | 20) & 0xFu; }
#define XB_SPIN(cond, bar) do { unsigned _sp = 0; while (cond) { __builtin_amdgcn_s_sleep(1); \
    if ((++_sp & 255u) == 0u) { if (xb_ld(&(bar)[XB_TMO])) break; if (_sp > XB_SPIN_CAP) { atomicAdd(&(bar)[XB_TMO], 1u); break; } } } } while (0)
struct XcdBarrier { unsigned* bar; unsigned x; volatile LAS unsigned* st; };
__device__ __forceinline__ XcdBarrier xcd_barrier_post(unsigned* bar, volatile LAS unsigned* st) {
  XcdBarrier b; b.bar = bar; b.x = xb_xcc_id(); b.st = st;
  if (opaque_tid() == 0) (void)xb_add(&bar[XB_XCNT(b.x)], 1u);
  return b;
}
__device__ __forceinline__ void xcd_barrier_complete(unsigned* bar, unsigned x, unsigned& nloc, unsigned& nx) {
  const unsigned G = gridDim.x * gridDim.y * gridDim.z;
  unsigned sum, cnt, mine, sp = 0u;
  for (;;) {
    sum = 0u; cnt = 0u; mine = 0u;
#pragma unroll
    for (unsigned j = 0; j < 16; ++j) { const unsigned c = xb_ld(&bar[XB_XCNT(j)]); sum += c; cnt += (c > 0u) ? 1u : 0u; mine = (j == x) ? c : mine; }
    if (sum == G) break;
    __builtin_amdgcn_s_sleep(1);
    if ((++sp & 255u) == 0u) { if (xb_ld(&bar[XB_TMO])) break; if (sp > XB_SPIN_CAP) { atomicAdd(&bar[XB_TMO], 1u); break; } }
  }
  nloc = mine > 0u ? mine : 1u; nx = cnt > 0u ? cnt : 1u;
}
__device__ __forceinline__ void xcd_barrier(const XcdBarrier& b) {
  asm volatile("s_waitcnt vmcnt(0)" ::: "memory");
  __syncthreads();
  if (opaque_tid() == 0) {
    unsigned* bar = b.bar;
    __builtin_amdgcn_s_waitcnt(0);
    unsigned nloc = b.st[0], nx = b.st[1];
    if (nloc == 0u) { xcd_barrier_complete(bar, b.x, nloc, nx); b.st[0] = nloc; b.st[1] = nx; }
    const unsigned old = xb_add(&bar[XB_XSUB(b.x)], 1u);
    const unsigned gen = old / nloc;
    if (old + 1u == (gen + 1u) * nloc) {
      __builtin_amdgcn_fence(__ATOMIC_RELEASE, "agent");
      asm volatile("s_waitcnt vmcnt(0)" ::: "memory");
      const unsigned og = xb_add(&bar[XB_TOP], 1u);
      const unsigned tg = og / nx;
      if (og + 1u == (tg + 1u) * nx) xb_add(&bar[XB_TOPGEN], 1u);
      else XB_SPIN(xb_ld(&bar[XB_TOPGEN]) == tg, bar);
      __builtin_amdgcn_fence(__ATOMIC_ACQUIRE, "agent");
      xb_add(&bar[XB_XGEN(b.x)], 1u);
      asm volatile("s_waitcnt vmcnt(0)" ::: "memory");
    } else {
      XB_SPIN(xb_ld(&bar[XB_XGEN(b.x)]) == gen, bar);
      __builtin_amdgcn_fence(__ATOMIC_ACQUIRE, "agent");
      asm volatile("s_waitcnt vmcnt(0)" ::: "memory");
    }
  }
  __syncthreads();
}

namespace pg8 {
constexpr int BM = 256, BK = 64, HALF = 128, HTB = HALF * BK * 2, STAGE_BYTES = 8 * HTB, NXCD = 8, WGM = 8;
__device__ __forceinline__ int lds_byte(int r, int c) { const int st = (r >> 4) * 2 + (c >> 5), rr = r & 15, cc = c & 31, ob = rr * 64 + cc * 2; return st * 1024 + (ob ^ (((ob >> 9) & 1) << 5)); }
__device__ __forceinline__ void stage_rc(int b, int& R, int& C) { const int st = b / 1024, sb = b % 1024, swz = sb ^ (((sb >> 9) & 1) << 5); R = (st >> 1) * 16 + swz / 64; C = (st & 1) * 32 + (swz % 64) / 2; }
__device__ __forceinline__ int perm32(int rho) { const int n = rho >> 4, i = rho & 15; return 8 * (i >> 2) + 4 * n + (i & 3); }
struct Unit { int pm, pn; };
struct Gemm { const bf16_t* A; const bf16_t* Bt; int lda, K, acol; };
struct StaticOrder {
  int nM, nN, nwg, G, c;
  __device__ void init(int M, int N, int G_, int c_) { nM = M / BM; nN = N / BM; nwg = nM * nN; G = G_; c = c_; }
  __device__ bool next(int i, Unit& u) const {
    const long L = (long)i * G + c; if (L >= nwg) return false;
    int wgid = (int)L; { const int q = nwg / NXCD, r = nwg % NXCD, xcd = wgid % NXCD, off = wgid / NXCD; wgid = (xcd < r ? xcd * (q + 1) : r * (q + 1) + (xcd - r) * q) + off; }
    const int nig = WGM * nN, gid = wgid / nig, fm = gid * WGM, gsz = (nM - fm) < WGM ? (nM - fm) : WGM;
    u.pm = fm + ((wgid % nig) % gsz); u.pn = (wgid % nig) / gsz; return true;
  }
};
struct OrderG1 {
  StaticOrder so;
  __device__ bool next(int i, Unit& u) const {
    if (so.next(i, u)) return true;
    const long L = (long)i * so.G + so.c;
    if (L >= so.nwg && L < so.nwg + 2) { u.pm = 128 + (int)(L - so.nwg); u.pn = 2; return true; }
    return false;
  }
};

template <class Epi, class Sched>
__device__ __forceinline__ void gemm_phase(LAS unsigned char* lds, const Gemm g, const Sched& S, const Epi& E) {
  const int tid = opaque_tid(), wid = __builtin_amdgcn_readfirstlane(tid >> 6), lane = tid & 63, wr = wid >> 2, wc = wid & 3, fr = lane & 15, fq = lane >> 4;
  const int K = g.K, nt = K / BK;
  unsigned voffA[2], voffB[2];
#pragma unroll
  for (int i = 0; i < 2; ++i) { int R, C; stage_rc(tid * 16 + i * 8192, R, C); const int Rb = Epi::PERM ? ((R & ~31) + perm32(R & 31)) : R;
    voffA[i] = (unsigned)(R * g.lda + C) * 2u; voffB[i] = (unsigned)(Rb * K + C) * 2u; }
  const size_t kstep = (size_t)(BK * 2);
  const size_t hstepA = (size_t)HALF * g.lda * 2, hstepB = (size_t)HALF * K * 2;
  const size_t tstepA = 2 * hstepA, tstepB = 2 * hstepB;
  const unsigned ldsw = (unsigned)wid * 1024u;
  const int aoff = lds_byte(wr * 64 + fr, fq * 8), boff = lds_byte(wc * 32 + fr, fq * 8);
#define PG8_SA(b, h) (((b) * 2 + (h)) * HTB)
#define PG8_SB(b, h) ((4 + (b) * 2 + (h)) * HTB)
#define PG8_STAGE(bufoff, gbase, voff) do { _Pragma("unroll") for (int _i = 0; _i < 2; ++_i) \
    __builtin_amdgcn_global_load_lds((const unsigned*)((const char*)(gbase) + (voff)[_i]), (LAS unsigned*)(lds + (bufoff) + ldsw + _i * 8192), 16, 0, 0); } while (0)
#define PG8_LDA(dst, b, h) do { _Pragma("unroll") for (int m = 0; m < 4; ++m) _Pragma("unroll") for (int k = 0; k < 2; ++k) dst[m][k] = *(const LAS bf16x8*)(lds + PG8_SA(b, h) + aoff + m * 2048 + k * 1024); } while (0)
#define PG8_LDB(dst, b, h) do { _Pragma("unroll") for (int n = 0; n < 2; ++n) _Pragma("unroll") for (int k = 0; k < 2; ++k) dst[n][k] = *(const LAS bf16x8*)(lds + PG8_SB(b, h) + boff + n * 2048 + k * 1024); } while (0)
#define PG8_MMA(ai, bj, At, Bt) do { __builtin_amdgcn_s_setprio(1); _Pragma("unroll") for (int m = 0; m < 4; ++m) _Pragma("unroll") for (int n = 0; n < 2; ++n) _Pragma("unroll") for (int k = 0; k < 2; ++k) \
    acc[ai][bj][m][n] = __builtin_amdgcn_mfma_f32_16x16x32_bf16(Bt[n][k], At[m][k], acc[ai][bj][m][n], 0, 0, 0); __builtin_amdgcn_s_setprio(0); } while (0)
#define PG8_WAIT_V(n) asm volatile("s_waitcnt vmcnt(" #n ")" ::: "memory")
#define PG8_WAIT_L(n) asm volatile("s_waitcnt lgkmcnt(" #n ")" ::: "memory")
#define PG8_BAR __builtin_amdgcn_s_barrier()
#define PG8_SCHED __builtin_amdgcn_sched_barrier(0)
  Unit cur, nxt; int ui = 0;
  if (!S.next(0, cur)) return;
  f32x4 acc[2][2][4][2];
#pragma unroll
  for (int a = 0; a < 2; ++a)
#pragma unroll
    for (int b = 0; b < 2; ++b)
#pragma unroll
      for (int m = 0; m < 4; ++m)
#pragma unroll
        for (int n = 0; n < 2; ++n) acc[a][b][m][n] = (f32x4){0.f, 0.f, 0.f, 0.f};
  bf16x8 At[4][2], B0[2][2], B1[2][2];
  const char* cA = (const char*)g.A + (size_t)cur.pm * tstepA + (size_t)cur.pn * g.acol * 2; const char* cB = (const char*)g.Bt + (size_t)cur.pn * tstepB;
  PG8_STAGE(PG8_SB(0, 0), cB, voffB); PG8_STAGE(PG8_SA(0, 0), cA, voffA); PG8_STAGE(PG8_SB(0, 1), cB + hstepB, voffB); PG8_STAGE(PG8_SA(0, 1), cA + hstepA, voffA);
  if (wr == 1) PG8_BAR;
  PG8_WAIT_V(4); PG8_BAR;
  PG8_STAGE(PG8_SB(1, 0), cB + kstep, voffB); PG8_STAGE(PG8_SA(1, 0), cA + kstep, voffA); PG8_STAGE(PG8_SB(1, 1), cB + hstepB + kstep, voffB);
  PG8_WAIT_V(6); PG8_BAR;
  for (;;) {
    const bool has_next = Epi::AFTER_DRAIN ? false : S.next(ui + 1, nxt);
    const char* nA = has_next ? (const char*)g.A + (size_t)nxt.pm * tstepA + (size_t)nxt.pn * g.acol * 2 : cA; const char* nB = has_next ? (const char*)g.Bt + (size_t)nxt.pn * tstepB : cB;
#pragma unroll 1
    for (int t = 0; t < nt; t += 2) {
      const bool last = (t == nt - 2);
      const bool pf = has_next || !last;
      const char* a1 = cA + (size_t)(t + 1) * kstep;
      const char* a2 = last ? nA : cA + (size_t)(t + 2) * kstep; const char* b2 = last ? nB : cB + (size_t)(t + 2) * kstep;
      const char* a3 = a2 + kstep; const char* b3 = b2 + kstep;
      PG8_LDB(B0, 0, 0); PG8_SCHED; PG8_LDA(At, 0, 0); PG8_STAGE(PG8_SA(1, 1), a1 + hstepA, voffA);
      PG8_WAIT_L(8); PG8_BAR; PG8_WAIT_L(0); PG8_MMA(0, 0, At, B0); PG8_BAR; PG8_SCHED;
      PG8_LDB(B1, 0, 1); if (pf) PG8_STAGE(PG8_SB(0, 0), b2, voffB);
      PG8_BAR; PG8_WAIT_L(0); PG8_MMA(0, 1, At, B1); PG8_BAR;
      PG8_LDA(At, 0, 1); if (pf) PG8_STAGE(PG8_SA(0, 0), a2, voffA);
      PG8_BAR; PG8_WAIT_L(0); PG8_MMA(1, 0, At, B0); PG8_BAR; PG8_SCHED;
      if (pf) { PG8_STAGE(PG8_SB(0, 1), b2 + hstepB, voffB); PG8_WAIT_V(6); } else PG8_WAIT_V(0);
      PG8_BAR; PG8_MMA(1, 1, At, B1); PG8_BAR;
      PG8_LDB(B0, 1, 0); PG8_SCHED; PG8_LDA(At, 1, 0); if (pf) PG8_STAGE(PG8_SA(0, 1), a2 + hstepA, voffA);
      PG8_WAIT_L(8); PG8_BAR; PG8_WAIT_L(0); PG8_MMA(0, 0, At, B0); PG8_BAR; PG8_SCHED;
      PG8_LDB(B1, 1, 1); if (pf) PG8_STAGE(PG8_SB(1, 0), b3, voffB);
      PG8_BAR; PG8_WAIT_L(0); PG8_MMA(0, 1, At, B1); PG8_BAR;
      PG8_LDA(At, 1, 1); if (pf) PG8_STAGE(PG8_SA(1, 0), a3, voffA);
      PG8_BAR; PG8_WAIT_L(0); PG8_MMA(1, 0, At, B0); PG8_BAR; PG8_SCHED;
      if (pf) { PG8_STAGE(PG8_SB(1, 1), b3 + hstepB, voffB); PG8_WAIT_V(6); }
      PG8_BAR; PG8_MMA(1, 1, At, B1); PG8_BAR;
    }
    if constexpr (!Epi::AFTER_DRAIN) E(acc, cur, wr, wc, fr, fq);
    if (!has_next) break;
#pragma unroll
    for (int a = 0; a < 2; ++a)
#pragma unroll
      for (int b = 0; b < 2; ++b)
#pragma unroll
        for (int m = 0; m < 4; ++m)
#pragma unroll
          for (int n = 0; n < 2; ++n) acc[a][b][m][n] = (f32x4){0.f, 0.f, 0.f, 0.f};
    cur = nxt; cA = nA; cB = nB; ++ui;
  }
  PG8_WAIT_V(0);
  if (wr == 0) PG8_BAR;
  PG8_BAR;
  if constexpr (Epi::AFTER_DRAIN) E.fused(acc, cur, wr, wc, fr, fq, lds, wid, lane);
#undef PG8_SA
#undef PG8_SB
#undef PG8_STAGE
#undef PG8_LDA
#undef PG8_LDB
#undef PG8_MMA
#undef PG8_WAIT_V
#undef PG8_WAIT_L
#undef PG8_BAR
#undef PG8_SCHED
}
}

struct EpiG1 {
  static constexpr bool PERM = false, AFTER_DRAIN = false;
  bf16_t *Qb, *Kb, *VT, *KC, *VCT, *Ub, *GT; const float* rope;
  __device__ __forceinline__ void operator()(const f32x4 (&acc)[2][2][4][2], const pg8::Unit& u, int wr, int wc, int fr, int fq) const {
    const int pn = u.pn;
    if (u.pm >= 128) {
#pragma unroll
      for (int ai = 0; ai < 2; ++ai)
#pragma unroll
        for (int m = 0; m < 4; ++m) {
          const int tc = (u.pm - 128) * 256 + 128 * ai + 64 * wr + 16 * m + fr, b = tc >> 8, cp = tc & 255;
#pragma unroll
          for (int n = 0; n < 2; ++n) {
            const f32x4 kv = acc[ai][0][m][n]; const int cc = 32 * wc + 16 * n + 4 * fq;
            u32x2 w; w.x = pk2(kv[0], kv[1]); w.y = pk2(kv[2], kv[3]); *(u32x2*)(KC + (size_t)tc * 128 + cc) = w;
            const f32x4 vv = acc[ai][1][m][n]; const int g = cc >> 6, d = cc & 63;
#pragma unroll
            for (int j = 0; j < 4; ++j) VCT[((size_t)((b * 2 + g) * 64 + d + j)) * 256 + cp] = (bf16_t)(pk2(vv[j], 0.f) & 0xffffu);
          }
        }
      return;
    }
#pragma unroll
    for (int ai = 0; ai < 2; ++ai)
#pragma unroll
      for (int m = 0; m < 4; ++m) {
        const int t = u.pm * 256 + 128 * ai + 64 * wr + 16 * m + fr, s = t & (SEQL - 1), b = t >> 14;
        if (pn <= 2) {
          const int pos = (wc & 1) ? (s & 63) : (s >> 6);
          const f32x4 cs = *(const f32x4*)(rope + pos * 16 + 4 * fq), sn = *(const f32x4*)(rope + 4096 + pos * 16 + 4 * fq);
#pragma unroll
          for (int bj = 0; bj < 2; ++bj) {
            const f32x4 x1 = acc[ai][bj][m][0], x2 = acc[ai][bj][m][1];
            if (pn < 2) {
              const f32x4 o1 = (x1 * cs - x2 * sn) * 0.18033688f, o2 = (x1 * sn + x2 * cs) * 0.18033688f;
              bf16_t* dst = Qb + (size_t)t * 512 + pn * 256 + 128 * bj + 32 * wc + 4 * fq;
              u32x2 w; w.x = pk2(o1[0], o1[1]); w.y = pk2(o1[2], o1[3]); *(u32x2*)dst = w;
              w.x = pk2(o2[0], o2[1]); w.y = pk2(o2[2], o2[3]); *(u32x2*)(dst + 16) = w;
            } else if (bj == 0) {
              const f32x4 o1 = x1 * cs - x2 * sn, o2 = x1 * sn + x2 * cs;
              bf16_t* dst = Kb + (size_t)t * 128 + 32 * wc + 4 * fq;
              u32x2 w; w.x = pk2(o1[0], o1[1]); w.y = pk2(o1[2], o1[3]); *(u32x2*)dst = w;
              w.x = pk2(o2[0], o2[1]); w.y = pk2(o2[2], o2[3]); *(u32x2*)(dst + 16) = w;
            } else {
#pragma unroll
              for (int n = 0; n < 2; ++n) {
                const f32x4 vv = n ? x2 : x1; const int cc = 32 * wc + 16 * n + 4 * fq, g = cc >> 6, d = cc & 63;
#pragma unroll
                for (int j = 0; j < 4; ++j) VT[((size_t)((b * 2 + g) * 64 + d + j)) * SEQL + s] = (bf16_t)(pk2(vv[j], 0.f) & 0xffffu);
              }
            }
          }
        } else if (pn <= 4) {
#pragma unroll
          for (int bj = 0; bj < 2; ++bj)
#pragma unroll
            for (int n = 0; n < 2; ++n) {
              const f32x4 v = acc[ai][bj][m][n];
              const f32x2 g0 = gelu_tanh2((f32x2){v[0], v[1]}), g1 = gelu_tanh2((f32x2){v[2], v[3]}); u32x2 w; w.x = pk2(g0.x, g0.y); w.y = pk2(g1.x, g1.y);
              *(u32x2*)(Ub + (size_t)t * 512 + (pn - 3) * 256 + 128 * bj + 32 * wc + 16 * n + 4 * fq) = w;
            }
        } else {
          const int tb = t >> 7, q = t & 127;
#pragma unroll
          for (int bj = 0; bj < 2; ++bj)
#pragma unroll
            for (int n = 0; n < 2; ++n) {
              const f32x4 v = acc[ai][bj][m][n]; const int cc = (pn - 5) * 256 + 128 * bj + 32 * wc + 16 * n + 4 * fq, grp = cc >> 6, d = cc & 63;
              { const f32x2 g0 = gelu_tanh2((f32x2){v[0], v[1]}), g1 = gelu_tanh2((f32x2){v[2], v[3]}); const float gv[4] = {g0.x, g0.y, g1.x, g1.y};
#pragma unroll
              for (int j = 0; j < 4; ++j) GT[((size_t)((tb * 8 + grp) * 64 + d + j)) * 128 + q] = (bf16_t)(pk2(gv[j], 0.f) & 0xffffu); }
            }
        }
      }
  }
};
struct EpiBf16 {
  static constexpr bool PERM = true, AFTER_DRAIN = false;
  bf16_t* O; int ldc;
  __device__ __forceinline__ void operator()(const f32x4 (&acc)[2][2][4][2], const pg8::Unit& u, int wr, int wc, int fr, int fq) const {
    const int col0 = u.pn * 256 + wc * 32 + 8 * fq;
#pragma unroll
    for (int ai = 0; ai < 2; ++ai)
#pragma unroll
      for (int m = 0; m < 4; ++m) { bf16_t* rowp = O + (size_t)(u.pm * 256 + 128 * ai + 64 * wr + 16 * m + fr) * ldc + col0;
#pragma unroll
        for (int bj = 0; bj < 2; ++bj) { const f32x4 v0 = acc[ai][bj][m][0], v1 = acc[ai][bj][m][1];
          u32x4 w; w.x = pk2(v0[0], v0[1]); w.y = pk2(v0[2], v0[3]); w.z = pk2(v1[0], v1[1]); w.w = pk2(v1[2], v1[3]); *(u32x4*)(rowp + bj * 128) = w; } }
  }
};

struct EpiF16 {
  static constexpr bool PERM = true, AFTER_DRAIN = false;
  unsigned short* O; int ldc;
  __device__ __forceinline__ void operator()(const f32x4 (&acc)[2][2][4][2], const pg8::Unit& u, int wr, int wc, int fr, int fq) const {
    const int col0 = u.pn * 256 + wc * 32 + 8 * fq;
#pragma unroll
    for (int ai = 0; ai < 2; ++ai)
#pragma unroll
      for (int m = 0; m < 4; ++m) { unsigned short* rowp = O + (size_t)(u.pm * 256 + 128 * ai + 64 * wr + 16 * m + fr) * ldc + col0;
#pragma unroll
        for (int bj = 0; bj < 2; ++bj) { const f32x4 v0 = acc[ai][bj][m][0], v1 = acc[ai][bj][m][1];
          u32x4 w; w.x = __builtin_bit_cast(unsigned, __builtin_amdgcn_cvt_pkrtz(v0[0], v0[1])); w.y = __builtin_bit_cast(unsigned, __builtin_amdgcn_cvt_pkrtz(v0[2], v0[3]));
          w.z = __builtin_bit_cast(unsigned, __builtin_amdgcn_cvt_pkrtz(v1[0], v1[1])); w.w = __builtin_bit_cast(unsigned, __builtin_amdgcn_cvt_pkrtz(v1[2], v1[3])); *(u32x4*)(rowp + bj * 128) = w; } }
  }
};

template <int LAYER> struct EpiResNorm {
  static constexpr bool PERM = true, AFTER_DRAIN = true;
  static constexpr int layer = LAYER; int b;
  __device__ __forceinline__ void fused(f32x4 (&acc)[2][2][4][2], const pg8::Unit& u, int wr, int wc, int fr, int fq, LAS unsigned char* lds, int wid, int lane) const {
    const Params p = load_params(); unsigned char* ws = p.ws; const float* mv = (const float*)(ws + WS_MOD) + (size_t)(layer == 0 ? b : 3 + b) * 6144;
    const float* xin = layer == 0 ? p.x : nullptr;
    bf16_t* XR = (bf16_t*)(ws + WS_XR); bf16_t* H = (bf16_t*)(ws + WS_H); unsigned char* HQ = ws + WS_HQ; unsigned char* HS = ws + WS_HS;
    const float* gate = mv + 2 * DM; const float* pscale = layer == 0 ? nullptr : p.pool_scale; const float* ng = p.norm2_g + layer * DM; const float* sc = mv + 4 * DM; const float* sh = mv + 3 * DM;
    float* xslot = (float*)(ws + WS_XSLOT) + (size_t)layer * 128 * 256 * 4; unsigned* cnt = (unsigned*)(ws + WS_XCNT) + (size_t)layer * 128 * 16; unsigned* bar = (unsigned*)(ws + WS_BAR);
    const int row0 = b * SEQL;
    LAS float* P = (LAS float*)lds;
    LAS float* S = (LAS float*)(lds + 8192);
    const int col0 = u.pn * 256 + wc * 32 + 8 * fq;
    const int pmg = (row0 >> 8) + u.pm;
    {
      f32x4 G[2][2];
#pragma unroll
      for (int bj = 0; bj < 2; ++bj)
#pragma unroll
        for (int n = 0; n < 2; ++n) { G[bj][n] = *(const f32x4*)(gate + col0 + 128 * bj + 4 * n); if constexpr (LAYER != 0) G[bj][n] = G[bj][n] * *(const f32x4*)(pscale + col0 + 128 * bj + 4 * n); }
      constexpr int RW = LAYER == 0 ? 3 : 4;
#pragma unroll
      for (int f0 = 0; f0 < 8; f0 += RW) {
        f32x4 bs[RW][2][2];
#pragma unroll
        for (int k = 0; k < RW; ++k) { const int f = f0 + k; if (f < 8) { const int ai = f >> 2, m = f & 3; const size_t row = (size_t)(row0 + u.pm * 256 + 128 * ai + 64 * wr + 16 * m + fr);
#pragma unroll
          for (int bj = 0; bj < 2; ++bj) {
            if constexpr (LAYER == 0) { bs[k][bj][0] = *(const f32x4*)(xin + row * DM + col0 + 128 * bj); bs[k][bj][1] = *(const f32x4*)(xin + row * DM + col0 + 128 * bj + 4); }
            else bs[k][bj][0] = __builtin_bit_cast(f32x4, *(const u32x4*)(XR + row * DM + col0 + 128 * bj)); } } }
#pragma unroll
        for (int k = 0; k < RW; ++k) { const int f = f0 + k; if (f < 8) { const int ai = f >> 2, m = f & 3; const int r = 128 * ai + 64 * wr + 16 * m + fr; const size_t row = (size_t)(row0 + u.pm * 256 + r);
          float ss = 0.f;
#pragma unroll
          for (int bj = 0; bj < 2; ++bj) {
            f32x4 b0 = bs[k][bj][0], b1 = bs[k][bj][1];
            if constexpr (LAYER != 0) { const u32x4 w = __builtin_bit_cast(u32x4, bs[k][bj][0]); b0 = (f32x4){bf_lo(w.x), bf_hi(w.x), bf_lo(w.y), bf_hi(w.y)}; b1 = (f32x4){bf_lo(w.z), bf_hi(w.z), bf_lo(w.w), bf_hi(w.w)}; }
            const f32x4 v0 = b0 + G[bj][0] * acc[ai][bj][m][0], v1 = b1 + G[bj][1] * acc[ai][bj][m][1];
            acc[ai][bj][m][0] = v0; acc[ai][bj][m][1] = v1;
            ss += ((v0[0] * v0[0] + v0[1] * v0[1]) + (v0[2] * v0[2] + v0[3] * v0[3])) + ((v1[0] * v1[0] + v1[1] * v1[1]) + (v1[2] * v1[2] + v1[3] * v1[3]));
            u32x4 w; w.x = pk2(v0[0], v0[1]); w.y = pk2(v0[2], v0[3]); w.z = pk2(v1[0], v1[1]); w.w = pk2(v1[2], v1[3]);
            *(u32x4*)(XR + row * DM + col0 + 128 * bj) = w; }
          ss = swap16_sum(ss, ss); ss = swap32_sum(ss, ss);
          if (fq == 0) P[r * 4 + wc] = ss; } }
      }
    }
    asm volatile("s_waitcnt lgkmcnt(0)" ::: "memory"); __builtin_amdgcn_s_barrier(); asm volatile("" ::: "memory");
    const int prow = wid * 32 + (lane & 31);
    if (lane < 32) { const float t = (P[prow * 4 + 0] + P[prow * 4 + 1]) + (P[prow * 4 + 2] + P[prow * 4 + 3]);
      __hip_atomic_store((unsigned*)xslot + ((size_t)(pmg * 256 + prow) * 4 + u.pn), __float_as_uint(t), __ATOMIC_RELAXED, __HIP_MEMORY_SCOPE_AGENT); }
    asm volatile("s_waitcnt vmcnt(0)" ::: "memory");
    if (lane == 0) __hip_atomic_fetch_add(cnt + 16 * pmg, 1u, __ATOMIC_RELAXED, __HIP_MEMORY_SCOPE_AGENT);
    if (wid == 0) { XB_SPIN((unsigned)__builtin_amdgcn_readfirstlane(__hip_atomic_load(cnt + 16 * pmg, __ATOMIC_RELAXED, __HIP_MEMORY_SCOPE_AGENT)) < 32u, bar);
      __builtin_amdgcn_fence(__ATOMIC_ACQUIRE, "agent"); }
    asm volatile("s_waitcnt vmcnt(0) lgkmcnt(0)" ::: "memory"); __builtin_amdgcn_s_barrier(); asm volatile("" ::: "memory");
    if (lane < 32) { const unsigned* sl = (const unsigned*)xslot + (size_t)(pmg * 256 + prow) * 4; float t[4];
#pragma unroll
      for (int q = 0; q < 4; ++q) t[q] = __uint_as_float(__hip_atomic_load(sl + q, __ATOMIC_RELAXED, __HIP_MEMORY_SCOPE_AGENT));
      S[prow] = rsqrtf(((t[0] + t[1]) + (t[2] + t[3])) * (1.0f / DM) + 1e-6f); }
    asm volatile("s_waitcnt vmcnt(0) lgkmcnt(0)" ::: "memory"); __builtin_amdgcn_s_barrier(); asm volatile("" ::: "memory");
    f32x4 A[2][2], B[2][2];
#pragma unroll
    for (int bj = 0; bj < 2; ++bj)
#pragma unroll
      for (int n = 0; n < 2; ++n) { A[bj][n] = *(const f32x4*)(ng + col0 + 128 * bj + 4 * n) * (*(const f32x4*)(sc + col0 + 128 * bj + 4 * n) + 1.0f); B[bj][n] = *(const f32x4*)(sh + col0 + 128 * bj + 4 * n); }
#pragma unroll
    for (int ai = 0; ai < 2; ++ai)
#pragma unroll
      for (int m = 0; m < 4; ++m) { const int r = 128 * ai + 64 * wr + 16 * m + fr; const size_t row = (size_t)(row0 + u.pm * 256 + r); const float rr = S[r];
#pragma unroll
        for (int bj = 0; bj < 2; ++bj) {
          const f32x4 y0 = (acc[ai][bj][m][0] * rr) * A[bj][0] + B[bj][0], y1 = (acc[ai][bj][m][1] * rr) * A[bj][1] + B[bj][1];
          u32x4 w; w.x = pk2(y0[0], y0[1]); w.y = pk2(y0[2], y0[3]); w.z = pk2(y1[0], y1[1]); w.w = pk2(y1[2], y1[3]);
          *(u32x4*)(H + row * DM + col0 + 128 * bj) = w;
          float am = fmaxf(fmaxf(fmaxf(fabsf(y0[0]), fabsf(y0[1])), fmaxf(fabsf(y0[2]), fabsf(y0[3]))), fmaxf(fmaxf(fabsf(y1[0]), fabsf(y1[1])), fmaxf(fabsf(y1[2]), fabsf(y1[3]))));
          am = xor32_max(xor16_max(am));
          const int s0 = max((int)(__float_as_uint(am) >> 23), 64) - 1;
          const float inv0 = __uint_as_float((unsigned)(254 - s0) << 23);
          const f32x2 f0 = (f32x2){y0[0], y0[1]} * inv0, f1 = (f32x2){y0[2], y0[3]} * inv0, f2 = (f32x2){y1[0], y1[1]} * inv0, f3 = (f32x2){y1[2], y1[3]} * inv0;
          unsigned w0 = __builtin_amdgcn_cvt_scalef32_pk_fp4_f32(0u, f0.x, f0.y, 1.0f, 0); w0 = __builtin_amdgcn_cvt_scalef32_pk_fp4_f32(w0, f1.x, f1.y, 1.0f, 1);
          w0 = __builtin_amdgcn_cvt_scalef32_pk_fp4_f32(w0, f2.x, f2.y, 1.0f, 2); w0 = __builtin_amdgcn_cvt_scalef32_pk_fp4_f32(w0, f3.x, f3.y, 1.0f, 3);
          const f32x2 r0 = (f0 - __builtin_amdgcn_cvt_scalef32_pk_f32_fp4(w0, 1.0f, 0)) * 4.0f, r1 = (f1 - __builtin_amdgcn_cvt_scalef32_pk_f32_fp4(w0, 1.0f, 1)) * 4.0f,
                      r2 = (f2 - __builtin_amdgcn_cvt_scalef32_pk_f32_fp4(w0, 1.0f, 2)) * 4.0f, r3 = (f3 - __builtin_amdgcn_cvt_scalef32_pk_f32_fp4(w0, 1.0f, 3)) * 4.0f;
          unsigned w1 = __builtin_amdgcn_cvt_scalef32_pk_fp4_f32(0u, r0.x, r0.y, 1.0f, 0); w1 = __builtin_amdgcn_cvt_scalef32_pk_fp4_f32(w1, r1.x, r1.y, 1.0f, 1);
          w1 = __builtin_amdgcn_cvt_scalef32_pk_fp4_f32(w1, r2.x, r2.y, 1.0f, 2); w1 = __builtin_amdgcn_cvt_scalef32_pk_fp4_f32(w1, r3.x, r3.y, 1.0f, 3);
          const int blk = 8 * u.pn + 4 * bj + wc;
          unsigned char* hq = HQ + row * 1024 + blk * 16 + 4 * fq;
          *(unsigned*)hq = w0; *(unsigned*)(hq + 512) = w1;
          if (fq == 0) HS[row * 32 + blk] = (unsigned char)s0; } }
    asm volatile("s_waitcnt lgkmcnt(0)" ::: "memory"); __builtin_amdgcn_s_barrier(); asm volatile("" ::: "memory");
  }
};

__device__ __forceinline__ void transpose_item(const float* W, int K, int N, bf16_t* WT, LAS float* scr, int item, int lane) {
  const int nblk = N / 32, kb = item / nblk, nb = item % nblk, k0 = 64 * kb, n0 = 32 * nb;
#pragma unroll 8
  for (int i = 0; i < 32; ++i) { const int kk = 2 * i + (lane >> 5); scr[kk * 33 + (lane & 31)] = W[(size_t)(k0 + kk) * N + n0 + (lane & 31)]; }
  asm volatile("s_waitcnt lgkmcnt(0)" ::: "memory");
  const int c = lane & 7;
#pragma unroll
  for (int j = 0; j < 4; ++j) { const int n = (lane >> 3) + 8 * j; const LAS float* s = scr + (8 * c) * 33 + n;
    u32x4 o; o.x = pk2(s[0 * 33], s[1 * 33]); o.y = pk2(s[2 * 33], s[3 * 33]); o.z = pk2(s[4 * 33], s[5 * 33]); o.w = pk2(s[6 * 33], s[7 * 33]);
    *(u32x4*)(WT + (size_t)(n0 + n) * K + k0 + 8 * c) = o; }
  asm volatile("s_waitcnt lgkmcnt(0)" ::: "memory");
}
__device__ __forceinline__ void convert_bf16(const float* src, bf16_t* dst, size_t n8, size_t i0, size_t stride) {
  for (size_t i = i0; i < n8; i += stride) { const f32x4 a = *(const f32x4*)(src + i * 8), b = *(const f32x4*)(src + i * 8 + 4);
    u32x4 o; o.x = pk2(a[0], a[1]); o.y = pk2(a[2], a[3]); o.z = pk2(b[0], b[1]); o.w = pk2(b[2], b[3]); *(u32x4*)(dst + i * 8) = o; }
}
__device__ __forceinline__ void convert_tables(const Params& p, int layer, int worker, int nworkers, int lane, int rbeg = 0, int rend = 2 * NEXP) {
  unsigned char* ws = p.ws;
  constexpr int RB = 4;
  float inv4[2], dq[2];
#pragma unroll
  for (int up = 0; up < 2; ++up) {
    const f32x4* src = (const f32x4*)((up ? p.peer_up : p.peer_down) + (size_t)layer * NEXP * DM) + lane;
    float ss = 0.f;
#pragma unroll
    for (int j = 0; j < 16; ++j) { const f32x4 t = src[(size_t)(j >> 2) * (NEXP / 4) * (DM / 4) + 64 * (j & 3)]; ss += (t[0] * t[0] + t[1] * t[1]) + (t[2] * t[2] + t[3] * t[3]); }
    const float ms = wave_sum(ss) * (1.0f / 4096.0f);
    inv4[up] = ms > 0.f ? 2.0f * rsqrtf(ms) : 0.f;
    dq[up] = 0.5f * sqrtf(ms);
    if (lane == 0) ((float*)(ws + WS_SD))[layer * 2 + up] = dq[up];
  }
#pragma unroll 1
  for (int row0 = rbeg + worker; row0 < rend; row0 += RB * nworkers) {
    f32x4 v[RB][4];
#pragma unroll
    for (int q = 0; q < RB; ++q) { const int row = min(row0 + q * nworkers, rend - 1); const int up = row >> 14, le = layer * NEXP + (row & (NEXP - 1));
      const f32x4* src = (const f32x4*)((up ? p.peer_up : p.peer_down) + (size_t)le * DM) + lane;
#pragma unroll
      for (int j = 0; j < 4; ++j) v[q][j] = src[64 * j]; }
#pragma unroll
    for (int q = 0; q < RB; ++q) { const int row = row0 + q * nworkers; if (row >= rend) break;
      const int up = row >> 14, e = row & (NEXP - 1);
      const float sc = up ? inv4[1] : inv4[0];
      unsigned char* d4 = ws + (up ? WS_TU4 : WS_TD4) + (size_t)layer * NEXP * 512 + (size_t)e * 128 + 2 * lane;
#pragma unroll
      for (int j = 0; j < 4; ++j) {
        const float x0 = __builtin_amdgcn_fmed3f(v[q][j][0] * sc, -6.0f, 6.0f), x1 = __builtin_amdgcn_fmed3f(v[q][j][1] * sc, -6.0f, 6.0f);
        const float x2 = __builtin_amdgcn_fmed3f(v[q][j][2] * sc, -6.0f, 6.0f), x3 = __builtin_amdgcn_fmed3f(v[q][j][3] * sc, -6.0f, 6.0f);
        unsigned w = __builtin_amdgcn_cvt_scalef32_pk_fp4_f32(0u, x0, x1, 1.0f, 0); w = __builtin_amdgcn_cvt_scalef32_pk_fp4_f32(w, x2, x3, 1.0f, 1);
        *(unsigned short*)(d4 + (size_t)j * NEXP * 128) = (unsigned short)w; }
    }
  }
}

__device__ __forceinline__ void phase_prep(const Params& p, LAS unsigned char* lds) {
  const int tid = opaque_tid(), lane = tid & 63, wave = tid >> 6;
  unsigned char* ws = p.ws;
  if (blockIdx.x < 192) {
    const int layer = blockIdx.x / 96, col = (blockIdx.x % 96) * 64 + (tid & 63), kg = tid >> 6;
    const float* W = p.mod_w + (size_t)layer * DM * 6144;
    LAS float* sv = (LAS float*)(lds + 8192);
    for (int i = tid; i < 3 * DM; i += NTHREADS) sv[i] = silu(i < 2 * DM ? p.c[i] : p.c_ctx[i - 2 * DM]);
    __syncthreads();
    float a0 = 0.f, a1 = 0.f, a2 = 0.f;
#pragma unroll 8
    for (int k = kg * 128; k < kg * 128 + 128; ++k) {
      const float w = W[(size_t)k * 6144 + col];
      a0 += sv[k] * w; a1 += sv[DM + k] * w; a2 += sv[2 * DM + k] * w;
    }
    LAS float* red = (LAS float*)lds;
    red[(kg * 3 + 0) * 64 + (tid & 63)] = a0; red[(kg * 3 + 1) * 64 + (tid & 63)] = a1; red[(kg * 3 + 2) * 64 + (tid & 63)] = a2;
    __syncthreads();
    if (tid < 192) { const int v = tid >> 6, cc = tid & 63; float sacc = 0.f;
#pragma unroll
      for (int g = 0; g < 8; ++g) sacc += red[(g * 3 + v) * 64 + cc];
      const int colg = (blockIdx.x % 96) * 64 + cc; sacc += p.mod_b[layer * 6144 + colg];
      float* MOD = (float*)(ws + WS_MOD);
      if (layer == 0) MOD[v * 6144 + colg] = sacc; else if (v < 2) MOD[(3 + v) * 6144 + colg] = sacc; }
    __syncthreads();
  }
  { const int i = blockIdx.x * NTHREADS + tid; if (i < 4096) { const int pos = i >> 4, f = i & 15; const float inv = powf(10000.0f, -(float)f / 16.0f), ang = (float)pos * inv;
      float* R = (float*)(ws + WS_ROPE); R[i] = cosf(ang); R[4096 + i] = sinf(ang); } }
  { LAS float* scr = (LAS float*)(lds + 8192 + wave * 8448);
    const int gw = blockIdx.x * NWAVES + wave, NGW = gridDim.x * NWAVES;
    constexpr int I_IN = 16 * 56, I_OUT = 16 * 32, I_Q = 16 * 64, I_P = 4 * 8;
    constexpr int NITEMS = I_IN + I_OUT + 4 * I_P;
    for (int it = gw; it < NITEMS; it += NGW) {
      int r = it;
      if (r < I_IN) { transpose_item(p.attn_in_w, DM, INW, (bf16_t*)(ws + WS_WIN), scr, r, lane); continue; } r -= I_IN;
      if (r < I_OUT) { transpose_item(p.attn_out_w, DM, DM, (bf16_t*)(ws + WS_WOUT), scr, r, lane); continue; } r -= I_OUT;
      const int g = r / I_P; r -= g * I_P;
      transpose_item(p.pool_w + (size_t)g * 256 * 256, 256, 256, (bf16_t*)(ws + WS_WPOOL) + (size_t)g * 256 * 256, scr, r, lane);
    }
  }
  { LAS float* As = (LAS float*)lds; LAS float* Ss = (LAS float*)(lds + 64 * 132 * 4);
    __syncthreads();
    for (int item = blockIdx.x; item < 2 * 16 * 16; item += gridDim.x) {
      const int kb = item & 15, hp = (item >> 4) & 15, l = item >> 8, pp = hp & 1;
      __syncthreads();
      f32x4 stg[12];
#pragma unroll
      for (int u = 0; u < 4; ++u) { const int i = tid + u * NTHREADS, row = i >> 5, c4 = i & 31;
        stg[u] = *(const f32x4*)(p.peer_w_q + ((size_t)l * DM + kb * 64 + row) * 2048 + hp * 128 + c4 * 4); }
#pragma unroll
      for (int u = 0; u < 8; ++u) { const int i = tid + u * NTHREADS, row = i >> 5, c4 = i & 31;
        stg[4 + u] = *(const f32x4*)(p.peer_sub_keys + (((size_t)l * 2 + pp) * 128 + row) * 128 + c4 * 4); }
#pragma unroll
      for (int u = 0; u < 4; ++u) { const int i = tid + u * NTHREADS, row = i >> 5, c4 = i & 31; *(LAS f32x4*)(As + row * 132 + c4 * 4) = stg[u]; }
#pragma unroll
      for (int u = 0; u < 8; ++u) { const int i = tid + u * NTHREADS, row = i >> 5, c4 = i & 31; *(LAS f32x4*)(Ss + row * 132 + c4 * 4) = stg[4 + u]; }
      __syncthreads();
      { const int li = lane & 15, g = lane >> 4;
        f32x4 dacc[4];
#pragma unroll
        for (int q = 0; q < 4; ++q) dacc[q] = (f32x4){0.f, 0.f, 0.f, 0.f};
#pragma unroll
        for (int s8 = 0; s8 < 8; ++s8) {
          const f32x4 sa = *(const LAS f32x4*)(Ss + (16 * wave + li) * 132 + 32 * g + 4 * s8);
          f32x4 ab[4];
#pragma unroll
          for (int q = 0; q < 4; ++q) ab[q] = *(const LAS f32x4*)(As + (16 * q + li) * 132 + 32 * g + 4 * s8);
#pragma unroll
          for (int e = 0; e < 4; ++e)
#pragma unroll
            for (int q = 0; q < 4; ++q) dacc[q] = __builtin_amdgcn_mfma_f32_16x16x4f32(sa[e], ab[q][e], dacc[q], 0, 0, 0);
        }
        bf16_t* dstb = (bf16_t*)(ws + WS_WQ) + ((size_t)l * 2048 + hp * 128 + 16 * wave + 4 * g) * DM + kb * 64 + li;
#pragma unroll
        for (int q = 0; q < 4; ++q)
#pragma unroll
          for (int r = 0; r < 4; ++r) dstb[(size_t)r * DM + 16 * q] = (bf16_t)(pk2(dacc[q][r], 0.f) & 0xffffu);
      }
    }
    __syncthreads();
  }
  { const size_t i0 = (size_t)blockIdx.x * NTHREADS + tid, stride = (size_t)gridDim.x * NTHREADS;
    convert_bf16(p.gmlp_w_s, (bf16_t*)(ws + WS_WS), 8 * 128 * 128 / 8, i0, stride);
  }
  convert_tables(p, 0, blockIdx.x * NWAVES + wave, gridDim.x * NWAVES, lane);
}


__device__ __forceinline__ int xcd_item(int rnd, int nitems) {
  const int G = gridDim.x;
  if ((G & 7) || (nitems & 7)) return (int)blockIdx.x + rnd * G;
  const int per = nitems >> 3, nb = G >> 3, j = (int)blockIdx.x >> 3, i = j + rnd * nb;
  return i < per ? ((int)blockIdx.x & 7) * per + i : nitems;
}
constexpr int KS_STRIDE = 144, VS_STRIDE = 272;
__device__ __forceinline__ void attn_phase(const Params& p, LAS unsigned char* lds) {
  unsigned char* ws = p.ws;
  const bf16_t* Qb = (const bf16_t*)(ws + WS_QB); const bf16_t* Kb = (const bf16_t*)(ws + WS_KB); const bf16_t* VT = (const bf16_t*)(ws + WS_VT);
  const bf16_t* KC = (const bf16_t*)(ws + WS_KC); const bf16_t* VCT = (const bf16_t*)(ws + WS_VCT); bf16_t* CAT = (bf16_t*)(ws + WS_CAT);
  const int tid = opaque_tid(), lane = tid & 63, wave = tid >> 6, fr = lane & 15, G = lane >> 4;
  LAS unsigned char* Ks0 = lds; LAS unsigned char* Vs0 = lds + 128 * KS_STRIDE; constexpr int ABUF = 128 * KS_STRIDE + 64 * VS_STRIDE;
  int par = 0;
  bool late;
  { LAS int* sid = (LAS int*)(lds + 122880); const int wv = __builtin_amdgcn_readfirstlane(wave), simd = ((int)__builtin_amdgcn_s_getreg((5 << 11) | 4) >> 4) & 3;
    if (lane == 0) sid[wv] = simd;
    __syncthreads();
    int lt = 0;
    for (int w2 = 0; w2 < wv; ++w2) lt |= (sid[w2] == simd) ? 1 : 0;
    late = __builtin_amdgcn_readfirstlane(lt) != 0; }
  u32x4 kreg[2], vreg[2]; bf16x8 Qf[2][2];
  auto fetch = [&](int b, int n, int g, int kb) {
    const int tile = n - 1 + kb;
#pragma unroll
    for (int i = 0; i < 2; ++i) {
      const int pc = tid + i * 512;
      { const int key = pc >> 3, ch = pc & 7;
        const bf16_t* src = (kb < 3) ? Kb + (size_t)(b * SEQL + tile * 128 + key) * 128 + g * 64 + ch * 8 : KC + (size_t)(b * CTXL + (kb - 3) * 128 + key) * 128 + g * 64 + ch * 8;
        kreg[i] = *(const u32x4*)src; }
      { const int d = pc >> 4, ch = pc & 15;
        const bf16_t* src = (kb < 3) ? VT + (size_t)((b * 2 + g) * 64 + d) * SEQL + tile * 128 + ch * 8 : VCT + (size_t)((b * 2 + g) * 64 + d) * CTXL + (kb - 3) * 128 + ch * 8;
        vreg[i] = *(const u32x4*)src; }
    }
  };
  auto loadq = [&](int it) {
    const int half = it & 1, g = (it >> 1) & 1, n = (it >> 2) & 127, b = it >> 9; const int hq = g * 4 + half * 2 + (wave >> 2), q0 = n * 128 + (wave & 3) * 32;
#pragma unroll
    for (int qt = 0; qt < 2; ++qt)
#pragma unroll
      for (int ks = 0; ks < 2; ++ks) Qf[qt][ks] = *(const bf16x8*)(Qb + (size_t)(b * SEQL + q0 + qt * 16 + fr) * 512 + hq * 64 + ks * 32 + 8 * G);
  };
  { const int it0 = xcd_item(0, 1024); if (it0 < 1024) { loadq(it0); const int n0 = (it0 >> 2) & 127; fetch(it0 >> 9, n0, (it0 >> 1) & 1, (n0 == 0) ? 1 : 0); } }
  for (int rnd = 0, item = xcd_item(0, 1024); item < 1024; item = xcd_item(++rnd, 1024)) {
    const int half = item & 1, g = (item >> 1) & 1, n = (item >> 2) & 127, b = item >> 9;
    const int hq = g * 4 + half * 2 + (wave >> 2), q0 = n * 128 + (wave & 3) * 32;
    const int nitem = xcd_item(rnd + 1, 1024);
    const float sink = p.attn_sink[hq] * 1.44269504f;
    float m_run[2] = {sink, sink}, l_run[2] = {0.25f, 0.25f};
    f32x4 O[4][2];
#pragma unroll
    for (int dt = 0; dt < 4; ++dt) { O[dt][0] = (f32x4){0.f, 0.f, 0.f, 0.f}; O[dt][1] = (f32x4){0.f, 0.f, 0.f, 0.f}; }
    const int kb_first = (n == 0) ? 1 : 0;
    bf16x8 Pf[4][2]; LAS unsigned char* Vp = Vs0; bool pend = false;
    auto pv = [&](LAS unsigned char* Vs) {
#pragma unroll
      for (int dt = 0; dt < 4; ++dt)
#pragma unroll
        for (int s = 0; s < 4; ++s) {
          const u32x2 v0 = *(const LAS u32x2*)(Vs + (16 * dt + fr) * VS_STRIDE + (32 * s + 4 * G) * 2), v1 = *(const LAS u32x2*)(Vs + (16 * dt + fr) * VS_STRIDE + (32 * s + 16 + 4 * G) * 2);
          u32x4 w; w.x = v0.x; w.y = v0.y; w.z = v1.x; w.w = v1.y; const bf16x8 vf = *(bf16x8*)&w;
          O[dt][0] = __builtin_amdgcn_mfma_f32_16x16x32_bf16(vf, Pf[s][0], O[dt][0], 0, 0, 0);
          O[dt][1] = __builtin_amdgcn_mfma_f32_16x16x32_bf16(vf, Pf[s][1], O[dt][1], 0, 0, 0);
        }
    };
    for (int kb = kb_first; kb < 5; ++kb) {
      const int tile = n - 1 + kb;
      if (kb == 2 && tile >= SEQL / 128) continue;
      LAS unsigned char* Ks = Ks0 + par * ABUF; LAS unsigned char* Vs = Vs0 + par * ABUF; par = (par == 2) ? 0 : par + 1;
#pragma unroll
      for (int i = 0; i < 2; ++i) { const int pc = tid + i * 512;
        *(LAS u32x4*)(Ks + (pc >> 3) * KS_STRIDE + (pc & 7) * 16) = kreg[i];
        *(LAS u32x4*)(Vs + (pc >> 4) * VS_STRIDE + (pc & 15) * 16) = vreg[i]; }
      { int kn = kb + 1; if (kn == 2 && n + 1 >= SEQL / 128) kn = 3;
        if (kn < 5) fetch(b, n, g, kn);
        else if (nitem < 1024) { const int nn = (nitem >> 2) & 127; fetch(nitem >> 9, nn, (nitem >> 1) & 1, (nn == 0) ? 1 : 0); } }
      __syncthreads();
      if (late && pend) pv(Vp);
      f32x4 S[8][2];
#pragma unroll
      for (int kt = 0; kt < 8; ++kt) {
        S[kt][0] = (f32x4){-m_run[0], -m_run[0], -m_run[0], -m_run[0]}; S[kt][1] = (f32x4){-m_run[1], -m_run[1], -m_run[1], -m_run[1]};
#pragma unroll
        for (int ks = 0; ks < 2; ++ks) {
          const bf16x8 kf = *(const LAS bf16x8*)(Ks + (16 * kt + fr) * KS_STRIDE + ks * 64 + G * 16);
          S[kt][0] = __builtin_amdgcn_mfma_f32_16x16x32_bf16(kf, Qf[0][ks], S[kt][0], 0, 0, 0);
          S[kt][1] = __builtin_amdgcn_mfma_f32_16x16x32_bf16(kf, Qf[1][ks], S[kt][1], 0, 0, 0);
        }
      }
      if (kb == 4 && nitem < 1024) loadq(nitem);
      if (kb == 0 || kb == 2) {
#pragma unroll
        for (int qt = 0; qt < 2; ++qt) { const int qpos = q0 + qt * 16 + fr;
#pragma unroll
          for (int kt = 0; kt < 8; ++kt)
#pragma unroll
            for (int r = 0; r < 4; ++r) { const int kpos = tile * 128 + 16 * kt + 4 * G + r; const bool ok = (kb == 0) ? (kpos >= qpos - 128) : (kpos <= qpos + 128);
              S[kt][qt][r] = ok ? S[kt][qt][r] : -INFINITY; } }
      }
#pragma unroll
      for (int qt = 0; qt < 2; ++qt) {
        float mx = S[0][qt][0];
#pragma unroll
        for (int kt = 0; kt < 8; ++kt)
#pragma unroll
          for (int r = 0; r < 4; ++r) mx = fmaxf(mx, S[kt][qt][r]);
        mx = xor32_max(xor16_max(mx));
        if (!__all(mx <= 8.0f)) {
          const float d = fmaxf(mx, 0.f), alpha = __builtin_amdgcn_exp2f(-d);
#pragma unroll
          for (int kt = 0; kt < 8; ++kt) S[kt][qt] = S[kt][qt] - d;
#pragma unroll
          for (int dt = 0; dt < 4; ++dt) O[dt][qt] = O[dt][qt] * alpha;
          l_run[qt] *= alpha; m_run[qt] += d;
        }
        f32x2 rs2 = (f32x2){0.f, 0.f};
#pragma unroll
        for (int kt = 0; kt < 8; ++kt) {
          f32x4 e;
#pragma unroll
          for (int r = 0; r < 4; ++r) e[r] = __builtin_amdgcn_exp2f(S[kt][qt][r]);
          S[kt][qt] = e; rs2 += (f32x2){e[0], e[1]}; rs2 += (f32x2){e[2], e[3]}; }
        l_run[qt] += rs2.x + rs2.y;
#pragma unroll
        for (int s = 0; s < 4; ++s) { u32x4 w; w.x = pk2(S[2 * s][qt][0], S[2 * s][qt][1]); w.y = pk2(S[2 * s][qt][2], S[2 * s][qt][3]); w.z = pk2(S[2 * s + 1][qt][0], S[2 * s + 1][qt][1]); w.w = pk2(S[2 * s + 1][qt][2], S[2 * s + 1][qt][3]);
          Pf[s][qt] = *(bf16x8*)&w; }
      }
      if (late) { Vp = Vs; pend = true; } else pv(Vs);
    }
    if (late && pend) pv(Vp);
#pragma unroll
    for (int qt = 0; qt < 2; ++qt) { float lt = swap16_sum(l_run[qt], l_run[qt]); lt = swap32_sum(lt, lt); const float inv = 1.0f / lt;
#pragma unroll
      for (int dt = 0; dt < 4; ++dt) { const f32x4 o = O[dt][qt] * inv; u32x2 w; w.x = pk2(o[0], o[1]); w.y = pk2(o[2], o[3]);
        *(u32x2*)(CAT + (size_t)(b * SEQL + q0 + qt * 16 + fr) * DM + hq * 64 + 16 * dt + 4 * G) = w; } }
  }
  __syncthreads();
}

__device__ __forceinline__ void gmlp_phase(const Params& p, LAS unsigned char* lds) {
  unsigned char* ws = p.ws;
  const bf16_t* GT = (const bf16_t*)(ws + WS_GT); const bf16_t* Ub = (const bf16_t*)(ws + WS_UB); const bf16_t* WSb = (const bf16_t*)(ws + WS_WS); bf16_t* CAT = (bf16_t*)(ws + WS_CAT);
  const int tid = opaque_tid(), lane = tid & 63, wave = tid >> 6, fr = lane & 15, G = lane >> 4;
  LAS unsigned char* Gs = lds; LAS float* mu = (LAS float*)(lds + 64 * VS_STRIDE); LAS float* rstd = mu + 128;
  u32x4 gpre[2];
  if ((int)blockIdx.x < 2048) { const int tb = (int)blockIdx.x >> 3, grp = (int)blockIdx.x & 7;
#pragma unroll
    for (int i = 0; i < 2; ++i) { const int pc = tid + i * 512, d = pc >> 4, ch = pc & 15; gpre[i] = *(const u32x4*)(GT + (size_t)((tb * 8 + grp) * 64 + d) * 128 + ch * 8); } }
  for (int item = blockIdx.x; item < 2048; item += gridDim.x) {
    const int tb = item >> 3, grp = item & 7;
    __syncthreads();
#pragma unroll
    for (int i = 0; i < 2; ++i) { const int pc = tid + i * 512, d = pc >> 4, ch = pc & 15; *(LAS u32x4*)(Gs + d * VS_STRIDE + ch * 16) = gpre[i]; }
    { const int nx = item + (int)gridDim.x;
      if (nx < 2048) { const int ntb = nx >> 3, ngrp = nx & 7;
#pragma unroll
        for (int i = 0; i < 2; ++i) { const int pc = tid + i * 512, d = pc >> 4, ch = pc & 15; gpre[i] = *(const u32x4*)(GT + (size_t)((ntb * 8 + ngrp) * 64 + d) * 128 + ch * 8); } } }
    const int prow = 16 * wave + fr; const size_t t = (size_t)tb * 128 + prow;
    bf16x8 wf[4]; u32x2 uu[4];
#pragma unroll
    for (int ks = 0; ks < 4; ++ks) wf[ks] = *(const bf16x8*)(WSb + (size_t)(grp * 128 + prow) * 128 + ks * 32 + 8 * G);
#pragma unroll
    for (int dt = 0; dt < 4; ++dt) uu[dt] = *(const u32x2*)(Ub + t * 512 + grp * 64 + 16 * dt + 4 * G);
    const float bias = p.gmlp_b_s[grp * 128 + prow];
    __syncthreads();
    if (tid < 128) { float s = 0.f, s2 = 0.f;
      for (int d = 0; d < 64; ++d) { const float v = __uint_as_float((unsigned)(*(const LAS bf16_t*)(Gs + d * VS_STRIDE + tid * 2)) << 16); s += v; }
      const float mean = s * (1.0f / 64.0f);
      for (int d = 0; d < 64; ++d) { const float v = __uint_as_float((unsigned)(*(const LAS bf16_t*)(Gs + d * VS_STRIDE + tid * 2)) << 16) - mean; s2 += v * v; }
      mu[tid] = mean; rstd[tid] = rsqrtf(s2 * (1.0f / 64.0f) + 1e-6f); }
    __syncthreads();
#pragma unroll
    for (int i = 0; i < 8; ++i) { const int e = tid + i * 512, d = e >> 6, qp = e & 63;
      LAS unsigned* wp = (LAS unsigned*)(Gs + d * VS_STRIDE + qp * 4); const unsigned w = *wp;
      *wp = pk2((bf_lo(w) - mu[2 * qp]) * rstd[2 * qp], (bf_hi(w) - mu[2 * qp + 1]) * rstd[2 * qp + 1]); }
    __syncthreads();
    f32x4 acc[4];
#pragma unroll
    for (int dt = 0; dt < 4; ++dt) acc[dt] = (f32x4){0.f, 0.f, 0.f, 0.f};
#pragma unroll
    for (int ks = 0; ks < 4; ++ks) {
#pragma unroll
      for (int dt = 0; dt < 4; ++dt) { const bf16x8 xf = *(const LAS bf16x8*)(Gs + (16 * dt + fr) * VS_STRIDE + ks * 64 + G * 16);
        acc[dt] = __builtin_amdgcn_mfma_f32_16x16x32_bf16(xf, wf[ks], acc[dt], 0, 0, 0); }
    }
#pragma unroll
    for (int dt = 0; dt < 4; ++dt) {
      u32x2 w; w.x = pk2(bf_lo(uu[dt].x) * (acc[dt][0] + bias), bf_hi(uu[dt].x) * (acc[dt][1] + bias)); w.y = pk2(bf_lo(uu[dt].y) * (acc[dt][2] + bias), bf_hi(uu[dt].y) * (acc[dt][3] + bias));
      *(u32x2*)(CAT + t * DM + 512 + grp * 64 + 16 * dt + 4 * G) = w; }
  }
  __syncthreads();
}

__device__ __forceinline__ void bitonic_merge16_desc(float (&v)[16]) {
#pragma unroll
  for (int j = 8; j > 0; j >>= 1)
#pragma unroll
    for (int i = 0; i < 16; ++i) { const int l = i ^ j; if (l > i) { const float a = v[i], b = v[l]; v[i] = fmaxf(a, b); v[l] = fminf(a, b); } }
}
__device__ __forceinline__ void merge_top16(float (&a)[16], const float (&b)[16]) {
#pragma unroll
  for (int i = 0; i < 8; ++i) { const float A = a[i], a2 = a[i + 8], B = b[7 - i], b2 = b[15 - i];
    a[i] = fmaxf(A, B); a[i + 8] = fmaxf(fmaxf(fminf(A, B), a2), b2); }
#pragma unroll
  for (int j = 4; j > 0; j >>= 1)
#pragma unroll
    for (int i = 0; i < 16; ++i) { const int l = i ^ j; if (l > i) { const float x = a[i], y = a[l]; a[i] = fmaxf(x, y); a[l] = fminf(x, y); } }
}
__device__ __forceinline__ float clr(float v, unsigned m) { return __uint_as_float(__float_as_uint(v) & ~m); }
__device__ __forceinline__ float cand(const float (&f0)[16], const float (&f1)[16], int a, int b) { return __uint_as_float((__float_as_uint(f0[a] + f1[b]) & ~0xffu) | (unsigned)(a * 16 + b)); }

__device__ __forceinline__ void ce_desc(float& a, float& b) { const float mx = fmaxf(a, b), mn = fminf(a, b); a = mx; b = mn; }
__device__ __forceinline__ void oe_sort16_desc(float (&v)[16]) {
  constexpr unsigned char N[63][2] = {{0,1}, {2,3}, {0,2}, {1,3}, {1,2}, {4,5}, {6,7}, {4,6}, {5,7}, {5,6}, {0,4}, {2,6}, {2,4}, {1,5}, {3,7}, {3,5}, {1,2}, {3,4}, {5,6}, {8,9}, {10,11}, {8,10}, {9,11}, {9,10}, {12,13}, {14,15}, {12,14}, {13,15}, {13,14}, {8,12}, {10,14}, {10,12}, {9,13}, {11,15}, {11,13}, {9,10}, {11,12}, {13,14}, {0,8}, {4,12}, {4,8}, {2,10}, {6,14}, {6,10}, {2,4}, {6,8}, {10,12}, {1,9}, {5,13}, {5,9}, {3,11}, {7,15}, {7,11}, {3,5}, {7,9}, {11,13}, {1,2}, {3,4}, {5,6}, {7,8}, {9,10}, {11,12}, {13,14}};
#pragma unroll
  for (int c = 0; c < 63; ++c) ce_desc(v[N[c][0]], v[N[c][1]]);
}
__device__ __forceinline__ float f16lo(unsigned w) { return (float)__builtin_bit_cast(_Float16, (unsigned short)(w & 0xffffu)); }
__device__ __forceinline__ float f16hi(unsigned w) { return (float)__builtin_bit_cast(_Float16, (unsigned short)(w >> 16)); }


__device__ __forceinline__ void topk_row(LAS unsigned char* rowp, int sw, size_t ob, unsigned short* IDX, bf16_t* A2) {
  float s0[16], s1[16];
#pragma unroll
  for (int pp = 0; pp < 2; ++pp) {
    float top[16];
#pragma unroll
    for (int c = 0; c < 8; ++c) {
      const u32x4 w0 = *(const LAS u32x4*)(rowp + pp * 256 + (((2 * c) ^ sw) * 16)), w1 = *(const LAS u32x4*)(rowp + pp * 256 + (((2 * c + 1) ^ sw) * 16));
      float ch[16];
#pragma unroll
      for (int j = 0; j < 4; ++j) {
        ch[2 * j]         = __uint_as_float((w0[j] << 16) | (unsigned)(16 * c + 2 * j));
        ch[2 * j + 1]     = __uint_as_float((w0[j] & 0xffff0000u) | (unsigned)(16 * c + 2 * j + 1));
        ch[8 + 2 * j]     = __uint_as_float((w1[j] << 16) | (unsigned)(16 * c + 8 + 2 * j));
        ch[8 + 2 * j + 1] = __uint_as_float((w1[j] & 0xffff0000u) | (unsigned)(16 * c + 8 + 2 * j + 1)); }
      oe_sort16_desc(ch);
      if (c == 0) {
#pragma unroll
        for (int i = 0; i < 16; ++i) top[i] = ch[i];
      } else merge_top16(top, ch);
    }
#pragma unroll
    for (int i = 0; i < 16; ++i) { if (pp == 0) s0[i] = top[i]; else s1[i] = top[i]; }
  }
#pragma unroll
  for (int i = 0; i < 16; ++i) { *(LAS float*)(rowp + ((i ^ sw) * 4)) = s0[i]; *(LAS float*)(rowp + 64 + ((i ^ sw) * 4)) = s1[i]; }
  float f0[16], f1[16];
#pragma unroll
  for (int i = 0; i < 16; ++i) { f0[i] = f16hi(__float_as_uint(s0[i])); f1[i] = f16hi(__float_as_uint(s1[i])); }
  float top[16];
#pragma unroll
  for (int b = 0; b < 16; ++b) top[b] = cand(f0, f1, 0, b);
  { float l1[16] = {cand(f0, f1, 1, 0), cand(f0, f1, 1, 1), cand(f0, f1, 1, 2), cand(f0, f1, 1, 3), cand(f0, f1, 1, 4), cand(f0, f1, 1, 5), cand(f0, f1, 1, 6), cand(f0, f1, 1, 7),
                    cand(f0, f1, 2, 0), cand(f0, f1, 2, 1), cand(f0, f1, 2, 2), cand(f0, f1, 2, 3), cand(f0, f1, 2, 4), cand(f0, f1, 3, 0), cand(f0, f1, 3, 1), cand(f0, f1, 3, 2)};
    oe_sort16_desc(l1); merge_top16(top, l1); }
  { float l2[16] = {cand(f0, f1, 3, 3), cand(f0, f1, 4, 0), cand(f0, f1, 4, 1), cand(f0, f1, 4, 2), cand(f0, f1, 5, 0), cand(f0, f1, 5, 1), cand(f0, f1, 6, 0), cand(f0, f1, 6, 1),
                    cand(f0, f1, 7, 0), cand(f0, f1, 7, 1), cand(f0, f1, 8, 0), cand(f0, f1, 9, 0), cand(f0, f1, 10, 0), cand(f0, f1, 11, 0), cand(f0, f1, 12, 0), cand(f0, f1, 13, 0)};
    oe_sort16_desc(l2); merge_top16(top, l2); }
  { float x = cand(f0, f1, 14, 0), y = cand(f0, f1, 15, 0); ce_desc(x, y); top[15] = fmaxf(top[15], x); top[14] = fmaxf(top[14], y); }
  float mx = clr(top[0], 255u);
#pragma unroll
  for (int i = 1; i < 16; ++i) mx = fmaxf(mx, clr(top[i], 255u));
  float e[16]; float sum = 0.f;
#pragma unroll
  for (int i = 0; i < 16; ++i) { e[i] = __expf(clr(top[i], 255u) - mx); sum += e[i]; }
  const float inv = 1.0f / sum;
  unsigned ex[16];
#pragma unroll
  for (int i = 0; i < 16; ++i) { const unsigned code = __float_as_uint(top[i]) & 255u; const unsigned a = code >> 4, b = code & 15u;
    const unsigned e0 = __float_as_uint(*(const LAS float*)(rowp + ((a ^ sw) * 4))) & 127u, e1 = __float_as_uint(*(const LAS float*)(rowp + 64 + ((b ^ sw) * 4))) & 127u;
    ex[i] = e0 * 128u + e1; }
  u32x4 iw0, iw1; iw0.x = ex[0] | (ex[1] << 16); iw0.y = ex[2] | (ex[3] << 16); iw0.z = ex[4] | (ex[5] << 16); iw0.w = ex[6] | (ex[7] << 16);
  iw1.x = ex[8] | (ex[9] << 16); iw1.y = ex[10] | (ex[11] << 16); iw1.z = ex[12] | (ex[13] << 16); iw1.w = ex[14] | (ex[15] << 16);
  *(u32x4*)(IDX + ob) = iw0; *(u32x4*)(IDX + ob + 8) = iw1;
  u32x4 a2w0, a2w1;
#pragma unroll
  for (int j = 0; j < 4; ++j) { a2w0[j] = pk2(e[2 * j] * inv, e[2 * j + 1] * inv); a2w1[j] = pk2(e[8 + 2 * j] * inv, e[9 + 2 * j] * inv); }
  *(u32x4*)(A2 + ob) = a2w0; *(u32x4*)(A2 + ob + 8) = a2w1;
}
struct EpiTopK {
  static constexpr bool PERM = true, AFTER_DRAIN = true;
  int layer, row0;
  __device__ __forceinline__ void fused(f32x4 (&acc)[2][2][4][2], const pg8::Unit& u, int wr, int wc, int fr, int fq, LAS unsigned char* lds, int wid, int lane) const {
#pragma unroll
    for (int ai = 0; ai < 2; ++ai)
#pragma unroll
      for (int m = 0; m < 4; ++m) { const int r = 128 * ai + 64 * wr + 16 * m + fr;
#pragma unroll
        for (int bj = 0; bj < 2; ++bj) { const f32x4 v0 = acc[ai][bj][m][0], v1 = acc[ai][bj][m][1];
          u32x4 w; w.x = __builtin_bit_cast(unsigned, __builtin_amdgcn_cvt_pkrtz(v0[0], v0[1])); w.y = __builtin_bit_cast(unsigned, __builtin_amdgcn_cvt_pkrtz(v0[2], v0[3]));
          w.z = __builtin_bit_cast(unsigned, __builtin_amdgcn_cvt_pkrtz(v1[0], v1[1])); w.w = __builtin_bit_cast(unsigned, __builtin_amdgcn_cvt_pkrtz(v1[2], v1[3]));
          *(LAS u32x4*)(lds + r * 512 + bj * 256 + (((4 * wc + fq) ^ (r & 15)) * 16)) = w; } }
    asm volatile("s_waitcnt lgkmcnt(0)" ::: "memory"); __builtin_amdgcn_s_barrier(); asm volatile("" ::: "memory");
    if (wid < 4) {
      const Params p = load_params(); unsigned char* ws = p.ws;
      const int r = wid * 64 + lane; const size_t t = (size_t)(row0 + u.pm * 256 + r);
      topk_row(lds + r * 512, lane & 15, t * 128 + u.pn * 16, (unsigned short*)(ws + WS_IDX), (bf16_t*)(ws + WS_GW) + (size_t)NT * 128);
    }
    asm volatile("s_waitcnt lgkmcnt(0)" ::: "memory"); __builtin_amdgcn_s_barrier(); asm volatile("" ::: "memory");
  }
};

struct PeerIdx { int v[16]; };
__device__ __forceinline__ PeerIdx peer_load_idx(const unsigned short* IDX, int t, int r) {
  PeerIdx o; const int tt = t < NT ? t : NT - 1;
#pragma unroll
  for (int j = 0; j < 2; ++j) { const u32x4 q = *(const u32x4*)(IDX + (size_t)tt * 128 + r * 16 + 8 * j);
#pragma unroll
    for (int k = 0; k < 4; ++k) { o.v[8 * j + 2 * k] = (int)(q[k] & 0xffffu); o.v[8 * j + 2 * k + 1] = (int)(q[k] >> 16); } }
  return o;
}
struct PeerRows { u32x4 d[16]; };
__device__ __forceinline__ PeerRows peer_gather(const unsigned char* T, const PeerIdx& ix, unsigned laneoff) {
  PeerRows o;
#pragma unroll
  for (int i = 0; i < 16; ++i) o.d[i] = *(const u32x4*)(T + (((unsigned)ix.v[i] << 7) + laneoff));
  return o;
}
typedef int i32x8 __attribute__((ext_vector_type(8)));
struct PeerA { u32x4 v; int scale; };
__device__ __forceinline__ void peer_down_token(const PeerRows& R, const PeerA A, bf16_t* dst, bool diag, bool b0, bool b1) {
  float E[32];
  const f32x4 z = (f32x4){0.f, 0.f, 0.f, 0.f};
  const i32x8 a = (i32x8){(int)A.v[0], (int)A.v[1], (int)A.v[2], (int)A.v[3], 0, 0, 0, 0};
#pragma unroll
  for (int g = 0; g < 16; ++g) {
    const i32x8 b = (i32x8){(int)R.d[g][0], (int)R.d[g][1], (int)R.d[g][2], (int)R.d[g][3], 0, 0, 0, 0};
    const f32x4 d = __builtin_amdgcn_mfma_scale_f32_16x16x128_f8f6f4(a, b, z, 4  , 4  , 0, A.scale, 0, 0x7f7f7f7f);
    E[2 * g] = diag ? d[0] + d[1] : 0.f; E[2 * g + 1] = diag ? d[2] + d[3] : 0.f; }
  float Rr[8], S[4], T[2];
#pragma unroll
  for (int G = 0; G < 8; ++G)
    Rr[G] = swap32_sum(swap16_sum(E[2 * G], E[2 * G + 1]), swap16_sum(E[2 * (G + 8)], E[2 * (G + 8) + 1]));
#pragma unroll
  for (int g0 = 0; g0 < 2; ++g0)
#pragma unroll
    for (int g2 = 0; g2 < 2; ++g2) { const float lo = Rr[g0 + 4 * g2], hi = Rr[g0 + 2 + 4 * g2];
      S[g0 + 2 * g2] = (b0 ? hi : lo) + dppf<0xB1>(b0 ? lo : hi); }
#pragma unroll
  for (int g0 = 0; g0 < 2; ++g0) T[g0] = (b1 ? S[g0 + 2] : S[g0]) + dppf<0x4E>(b1 ? S[g0] : S[g0 + 2]);
  *(unsigned*)dst = pk2(T[0], T[1]);
}
__device__ __forceinline__ void peer_down_phase(const Params& p, int layer) {
  unsigned char* ws = p.ws;
  const int tid = opaque_tid(), lane = tid & 63, wave = tid >> 6, kg = lane >> 4, m = lane & 15, u = (lane >> 2) & 3, v = lane & 3;
  const int x = blockIdx.x & 7, rank = blockIdx.x >> 3, nslot = (gridDim.x >> 3) * NWAVES;
  if (rank >= (int)(gridDim.x >> 3)) return;
  const int sl = x & 3, te = ((x >> 2) + 1) * (NT / 2);
  const int q = 2 * u + (kg >> 1);
  const unsigned short* IDX = (const unsigned short*)(ws + WS_IDX);
  const unsigned char* TD = ws + WS_TD4 + (size_t)layer * NEXP * 512 + (size_t)sl * NEXP * 128; const unsigned laneoff = 16 * (4 * (kg & 1) + v);
  bf16_t* PART = (bf16_t*)(ws + WS_PART) + (size_t)sl * NT * 128 + 16 * (2 * u + (kg & 1)) + 8 * (kg >> 1) + 2 * v;
  const int blk = 8 * sl + 4 * (kg & 1) + (m >> 2);
  const unsigned char* HQl = ws + WS_HQ + (m & 1) * 512 + blk * 16; const unsigned char* HSl = ws + WS_HS + blk;
  const bool live = (kg >> 1) == ((m >> 1) & 1), diag = kg == v, b0 = (v & 1) != 0, b1 = (v & 2) != 0; const int sdec = 2 * (m & 1);
  int t = (x >> 2) * (NT / 2) + rank * NWAVES + wave;
  PeerIdx ia = peer_load_idx(IDX, t, q), ib = peer_load_idx(IDX, t + nslot, q);
  PeerRows ra = peer_gather(TD, ia, laneoff), rb;
  u32x4 ha, hb; unsigned sa, sb;
  { const int tc = t < te ? t : te - 1; ha = *(const u32x4*)(HQl + (size_t)tc * 1024); sa = HSl[(size_t)tc * 32]; }
#pragma unroll 1
  for (; t < te; t += 2 * nslot) {
    { const int tn = t + nslot, tc = tn < te ? tn : te - 1;
      rb = peer_gather(TD, ib, laneoff); hb = *(const u32x4*)(HQl + (size_t)tc * 1024); sb = HSl[(size_t)tc * 32];
      ia = peer_load_idx(IDX, t + 2 * nslot, q);
      PeerA A;
#pragma unroll
      for (int j = 0; j < 4; ++j) A.v[j] = live ? ha[j] : 0u;
      A.scale = (int)sa - sdec;
      peer_down_token(ra, A, PART + (size_t)t * 128, diag, b0, b1); }
    { const int tn = t + nslot; if (tn >= te) break;
      const int t2 = t + 2 * nslot, tc = t2 < te ? t2 : te - 1;
      ra = peer_gather(TD, ia, laneoff); ha = *(const u32x4*)(HQl + (size_t)tc * 1024); sa = HSl[(size_t)tc * 32];
      ib = peer_load_idx(IDX, t + 3 * nslot, q);
      PeerA A;
#pragma unroll
      for (int j = 0; j < 4; ++j) A.v[j] = live ? hb[j] : 0u;
      A.scale = (int)sb - sdec;
      peer_down_token(rb, A, PART + (size_t)tn * 128, diag, b0, b1); }
  }
}
__device__ __forceinline__ void peer_reduce_phase(const Params& p, int layer) {
  unsigned char* ws = p.ws;
  const int tid = opaque_tid();
  const bf16_t* PART = (const bf16_t*)(ws + WS_PART); const bf16_t* A1 = (const bf16_t*)(ws + WS_GW); const bf16_t* A2 = A1 + (size_t)NT * 128; bf16_t* CFo = (bf16_t*)(ws + WS_CF);
  constexpr int UB = 4;
  const float gsd = ((const float*)(ws + WS_SD))[layer * 2], gsu = ((const float*)(ws + WS_SD))[layer * 2 + 1];
  const size_t stride = (size_t)gridDim.x * NTHREADS, ngrp = (size_t)NT * 16;
#pragma unroll 1
  for (size_t i0 = (size_t)blockIdx.x * NTHREADS + tid; i0 < ngrp; i0 += UB * stride) {
    u32x4 pw[UB][4], a2[UB];
#pragma unroll
    for (int u = 0; u < UB; ++u) { const size_t i = min(i0 + u * stride, ngrp - 1);
#pragma unroll
      for (int x = 0; x < 4; ++x) pw[u][x] = *(const u32x4*)(PART + (size_t)x * NT * 128 + i * 8);
      a2[u] = *(const u32x4*)(A2 + i * 8); }
#pragma unroll
    for (int u = 0; u < UB; ++u) { const size_t i = i0 + u * stride; if (i >= ngrp) break;
      float a[8];
#pragma unroll
      for (int j = 0; j < 8; ++j) a[j] = 0.f;
#pragma unroll
      for (int x = 0; x < 4; ++x)
#pragma unroll
        for (int j = 0; j < 4; ++j) { a[2 * j] += bf_lo(pw[u][x][j]); a[2 * j + 1] += bf_hi(pw[u][x][j]); }
      f32x2 cf[4];
#pragma unroll
      for (int j = 0; j < 4; ++j) cf[j] = ((f32x2){bf_lo(a2[u][j]), bf_hi(a2[u][j])} * gsu) * gelu_tanh2((f32x2){a[2 * j], a[2 * j + 1]} * gsd);
      float am = 0.f;
#pragma unroll
      for (int j = 0; j < 4; ++j) am = fmaxf(am, fmaxf(fabsf(cf[j].x), fabsf(cf[j].y)));
      am = fmaxf(am, dppf<0xB1>(am)); am = fmaxf(am, dppf<0x4E>(am));
      const int s0 = max((int)(__float_as_uint(am) >> 23), 64) - 1;
      const float inv0 = __uint_as_float((unsigned)(254 - s0) << 23);
      unsigned w0 = 0u, w1 = 0u, w2 = 0u;
#define PEER_Q_BYTE(b) { const f32x2 fs = cf[b] * inv0; \
      w0 = __builtin_amdgcn_cvt_scalef32_pk_fp4_f32(w0, fs.x, fs.y, 1.0f, b); \
      const f32x2 r1 = (fs - __builtin_amdgcn_cvt_scalef32_pk_f32_fp4(w0, 1.0f, b)) * 4.0f; \
      w1 = __builtin_amdgcn_cvt_scalef32_pk_fp4_f32(w1, r1.x, r1.y, 1.0f, b); \
      const f32x2 r2 = (r1 - __builtin_amdgcn_cvt_scalef32_pk_f32_fp4(w1, 1.0f, b)) * 4.0f; \
      w2 = __builtin_amdgcn_cvt_scalef32_pk_fp4_f32(w2, r2.x, r2.y, 1.0f, b); }
      PEER_Q_BYTE(0) PEER_Q_BYTE(1) PEER_Q_BYTE(2) PEER_Q_BYTE(3)
#undef PEER_Q_BYTE
      unsigned char* rec = (unsigned char*)CFo + (i >> 4) * 256; const int G = (int)(i & 15);
      unsigned* q = (unsigned*)(rec + (G >> 2) * 16 + (G & 3) * 4);
      q[0] = w0; q[16] = w1; q[32] = w2;
      if ((G & 3) == 0) rec[192 + (G >> 2)] = (unsigned char)s0;
      }
  }
}
typedef int i32x2 __attribute__((ext_vector_type(2)));
__device__ __forceinline__ void peer_up_stage(const PeerRows& R, LAS unsigned char* wl, unsigned W0) {
  asm volatile("" : "+v"(W0));
#pragma unroll
  for (int g = 0; g < 16; ++g) {
    const unsigned k = 16u * ((g >> 1) & 7) + 128u * g;
    *(LAS u32x2*)(wl + (W0 ^ k)) = (u32x2){R.d[g][0], R.d[g][1]};
    *(LAS u32x2*)(wl + (W0 ^ (k + 8u))) = (u32x2){R.d[g][2], R.d[g][3]}; }
}
__device__ __forceinline__ void peer_up_token(const PeerA A, LAS unsigned char* wl, unsigned R0, int lane, bf16_t* xr, u32x2 xw, f32x4 gg) {
  asm volatile("" : "+v"(R0));
  const f32x4 z = (f32x4){0.f, 0.f, 0.f, 0.f};
  const i32x8 a = (i32x8){(int)A.v[0], (int)A.v[1], (int)A.v[2], (int)A.v[3], 0, 0, 0, 0};
  float o16[16];
#pragma unroll
  for (int T = 0; T < 16; ++T) {
    const i32x2 b0 = __builtin_amdgcn_ds_read_tr4_b64_v2i32((LAS i32x2*)(wl + (R0 ^ (8u * T)))), b1 = __builtin_amdgcn_ds_read_tr4_b64_v2i32((LAS i32x2*)(wl + ((R0 ^ 128u ^ (8u * T)) + 2048)));
    const i32x8 b = (i32x8){b0[0], b0[1], b1[0], b1[1], 0, 0, 0, 0};
    const f32x4 d = __builtin_amdgcn_mfma_scale_f32_16x16x128_f8f6f4(a, b, z, 4, 4, 0, A.scale, 0, 0x7f7f7f7f);
    o16[T] = (d[0] + d[1]) + d[2];
    if ((T & 3) == 3) __builtin_amdgcn_sched_barrier(0); }
#pragma unroll
  for (int T = 0; T < 16; ++T) *(LAS float*)(wl + T * 256 + lane * 4) = o16[T];
  const f32x4 v = *(const LAS f32x4*)(wl + (lane >> 2) * 256 + (lane & 3) * 16);
  u32x2 w; w.x = pk2(bf_lo(xw.x) + gg[0] * v[0], bf_hi(xw.x) + gg[1] * v[1]); w.y = pk2(bf_lo(xw.y) + gg[2] * v[2], bf_hi(xw.y) + gg[3] * v[3]);
  *(u32x2*)xr = w;
}
struct PeerARaw { u32x4 v; unsigned sc; };
__device__ __forceinline__ PeerARaw peer_load_a(const unsigned char* CFQ, int t, int aoff) { PeerARaw o; const unsigned char* rec = CFQ + (size_t)t * 256; o.v = *(const u32x4*)(rec + aoff); o.sc = *(const unsigned*)(rec + 192); return o; }
__device__ __forceinline__ PeerA peer_make_a(const PeerARaw& q, int st, int kg, bool live) {
  PeerA o;
#pragma unroll
  for (int j = 0; j < 4; ++j) o.v[j] = live ? q.v[j] : 0u;
  o.scale = (int)((q.sc >> (8 * kg)) & 255u) - 2 * st;
  return o;
}
__device__ __forceinline__ void peer_up_phase(const Params& p, LAS unsigned char* lds, int layer) {
  unsigned char* ws = p.ws;
  const int tid = opaque_tid(), lane = tid & 63, wave = tid >> 6, r = lane >> 3, c = lane & 7, n = lane & 15, kg = lane >> 4;
  const int x = blockIdx.x & 7, rank = blockIdx.x >> 3, nslot = (gridDim.x >> 3) * NWAVES;
  if (rank >= (int)(gridDim.x >> 3)) return;
  const int sl = x & 3, te = ((x >> 2) + 1) * (NT / 2);
  LAS unsigned char* wl = lds + wave * 16384;
  const unsigned W0 = (unsigned)(16 * r * 128 + 128 * (r & 1) + 16 * c + 8 * ((r >> 1) & 1));
  const unsigned R0 = (unsigned)((32 * kg + n) * 128 + 16 * ((n >> 1) & 7) + 8 * (kg & 1));
  const unsigned short* IDX = (const unsigned short*)(ws + WS_IDX); const unsigned char* CFQ = ws + WS_CF; const float* MOD = (const float*)(ws + WS_MOD);
  const unsigned char* TU = ws + WS_TU4 + (size_t)layer * NEXP * 512 + (size_t)sl * NEXP * 128; const unsigned laneoff = 16 * c;
  const int col = 256 * sl + 4 * lane;
  bf16_t* XR = (bf16_t*)(ws + WS_XR) + col;
  const float* g2b = MOD + (size_t)(layer == 0 ? 0 : 3) * 6144 + 5 * DM + col;
  const int st = lane & 15; const bool live = st < 3; const int aoff = ((live ? st : 0) * 4 + kg) * 16;
  int t = (x >> 2) * (NT / 2) + rank * NWAVES + wave;
  PeerIdx ia = peer_load_idx(IDX, t, r), ib = peer_load_idx(IDX, t + nslot, r);
  PeerRows ra = peer_gather(TU, ia, laneoff), rb = peer_gather(TU, ib, laneoff);
  ia = peer_load_idx(IDX, t + 2 * nslot, r); ib = peer_load_idx(IDX, t + 3 * nslot, r);
  PeerARaw qa = peer_load_a(CFQ, min(t, te - 1), aoff), qb;
  u32x2 xa = *(const u32x2*)(XR + (size_t)min(t, te - 1) * DM), xb;
  const f32x4 gg = *(const f32x4*)(g2b + (size_t)(x >> 2) * 6144);
  __syncthreads();
#pragma unroll 1
  for (; t < te; t += 2 * nslot) {
    { const int tc = min(t + nslot, te - 1);
      peer_up_stage(ra, wl, W0); __builtin_amdgcn_sched_barrier(0);
      ra = peer_gather(TU, ia, laneoff); ia = peer_load_idx(IDX, t + 4 * nslot, r); __builtin_amdgcn_sched_barrier(0);
      qb = peer_load_a(CFQ, tc, aoff); xb = *(const u32x2*)(XR + (size_t)tc * DM);
      peer_up_token(peer_make_a(qa, st, kg, live), wl, R0, lane, XR + (size_t)t * DM, xa, gg); }
    { const int tn = t + nslot; if (tn >= te) break;
      const int tc = min(t + 2 * nslot, te - 1);
      peer_up_stage(rb, wl, W0); __builtin_amdgcn_sched_barrier(0);
      rb = peer_gather(TU, ib, laneoff); ib = peer_load_idx(IDX, t + 5 * nslot, r); __builtin_amdgcn_sched_barrier(0);
      qa = peer_load_a(CFQ, tc, aoff); xa = *(const u32x2*)(XR + (size_t)tc * DM);
      peer_up_token(peer_make_a(qb, st, kg, live), wl, R0, lane, XR + (size_t)tn * DM, xb, gg); }
  }
}
__device__ __forceinline__ void final_norm_phase(const Params& p) {
  const int tid = opaque_tid(), lane = tid & 63, wave = tid >> 6;
  const int gw = blockIdx.x * NWAVES + wave, NGW = gridDim.x * NWAVES;
  constexpr int RB = 4;
  f32x4 FG[4];
#pragma unroll
  for (int j = 0; j < 4; ++j) FG[j] = ((const f32x4*)p.final_g)[lane + 64 * j];
#pragma unroll 1
  for (int r0 = gw; r0 < NT; r0 += RB * NGW) {
    f32x4 v[RB][4];
#pragma unroll
    for (int q = 0; q < RB; ++q) { const int r = min(r0 + q * NGW, NT - 1); const u32x2* xr = (const u32x2*)((const bf16_t*)(p.ws + WS_XR) + (size_t)r * DM) + lane;
#pragma unroll
      for (int j = 0; j < 4; ++j) { const u32x2 w = xr[64 * j]; v[q][j] = (f32x4){bf_lo(w.x), bf_hi(w.x), bf_lo(w.y), bf_hi(w.y)}; } }
#pragma unroll
    for (int q = 0; q < RB; ++q) { const int r = r0 + q * NGW; if (r >= NT) break;
      float ss = 0.f;
#pragma unroll
      for (int j = 0; j < 4; ++j) ss += (v[q][j][0] * v[q][j][0] + v[q][j][1] * v[q][j][1]) + (v[q][j][2] * v[q][j][2] + v[q][j][3] * v[q][j][3]);
      const float rr = rsqrtf(wave_sum(ss) * (1.0f / DM) + 1e-6f);
      f32x4* xo = (f32x4*)(p.out + (size_t)r * DM) + lane;
#pragma unroll
      for (int j = 0; j < 4; ++j) __builtin_nontemporal_store(v[q][j] * rr * FG[j], xo + 64 * j);
    }
  }
}

__device__ __forceinline__ void pool_fused_phase(const Params& p, LAS unsigned char* lds) {
  unsigned char* ws = p.ws;
  const int tid = opaque_tid(), lane = tid & 63, wave = tid >> 6;
  const float* MOD = (const float*)(ws + WS_MOD); bf16_t* PO = (bf16_t*)(ws + WS_CAT);
  const float* ng = p.norm1_g + DM;
  u32x2 pre[6][4];
  auto fetch_rows = [&](int tile) {
    const int t0 = tile * 32, s0 = t0 & (SEQL - 1), b = t0 >> 14;
#pragma unroll
    for (int q = 0; q < 6; ++q) { const int pos = min(max(s0 - 8 + wave + q * NWAVES, 0), SEQL - 1); const u32x2* xr = (const u32x2*)((const bf16_t*)(ws + WS_XR) + (size_t)(b * SEQL + pos) * DM) + lane;
#pragma unroll
      for (int e = 0; e < 4; ++e) pre[q][e] = xr[64 * e]; }
  };
  if (xcd_item(0, NT / 32) < NT / 32) fetch_rows(xcd_item(0, NT / 32));
#pragma unroll 1
  for (int rnd = 0, tile = xcd_item(0, NT / 32); tile < NT / 32; tile = xcd_item(++rnd, NT / 32)) {
    const int t0 = tile * 32, s0 = t0 & (SEQL - 1), b = t0 >> 14;
    const float* sh = MOD + (size_t)(3 + b) * 6144; const float* sc = sh + DM;
    f32x4 PA[4], PB[4];
#pragma unroll
    for (int e = 0; e < 4; ++e) { PA[e] = ((const f32x4*)ng)[lane + 64 * e] * (((const f32x4*)sc)[lane + 64 * e] + 1.0f); PB[e] = ((const f32x4*)sh)[lane + 64 * e]; }
    __syncthreads();
#pragma unroll
    for (int q = 0; q < 6; ++q) { const int j = wave + q * NWAVES, pos = s0 - 8 + j;
      if (pos >= 0 && pos < SEQL) {
        f32x4 v[4]; float ss = 0.f;
#pragma unroll
        for (int e = 0; e < 4; ++e) { const u32x2 w = pre[q][e]; v[e] = (f32x4){bf_lo(w.x), bf_hi(w.x), bf_lo(w.y), bf_hi(w.y)}; ss += (v[e][0] * v[e][0] + v[e][1] * v[e][1]) + (v[e][2] * v[e][2] + v[e][3] * v[e][3]); }
        const float r = rsqrtf(wave_sum(ss) * (1.0f / DM) + 1e-6f);
        LAS u32x2* o8 = (LAS u32x2*)(lds + j * 2048) + lane;
#pragma unroll
        for (int e = 0; e < 4; ++e) { const f32x4 y = (v[e] * r) * PA[e] + PB[e]; u32x2 w; w.x = pk2(y[0], y[1]); w.y = pk2(y[2], y[3]); o8[64 * e] = w; }
      }
    }
    __syncthreads();
    if (xcd_item(rnd + 1, NT / 32) < NT / 32) fetch_rows(xcd_item(rnd + 1, NT / 32));
    { auto pool_tok = [&](auto HWc, int tok, int grp) {
        constexpr int HW = decltype(HWc)::value;
        const int ch = grp * 32 + (lane & 31);
        const int sq = s0 + tok;
        u32x4 w[2 * HW];
#pragma unroll
        for (int q = 0; q < 2 * HW; ++q) w[q] = *(const LAS u32x4*)(lds + (tok + 8 - HW + q) * 2048 + ch * 16);
        const u32x4 c = *(const LAS u32x4*)(lds + (tok + 8) * 2048 + ch * 16);
        float sum[8]; float cnt = 0.f;
#pragma unroll
        for (int j = 0; j < 8; ++j) sum[j] = 0.f;
#pragma unroll
        for (int q = 0; q < 2 * HW; ++q) { const int pos = sq - HW + q; const bool ok = (pos >= 0 && pos < SEQL); cnt += ok ? 1.0f : 0.0f;
#pragma unroll
          for (int j = 0; j < 4; ++j) { sum[2 * j] += ok ? bf_lo(w[q][j]) : 0.0f; sum[2 * j + 1] += ok ? bf_hi(w[q][j]) : 0.0f; } }
        const float inv = 1.0f / cnt; u32x4 o;
#pragma unroll
        for (int j = 0; j < 4; ++j) o[j] = pk2(sum[2 * j] * inv - bf_lo(c[j]), sum[2 * j + 1] * inv - bf_hi(c[j]));
        *(u32x4*)(PO + (size_t)(t0 + tok) * DM + ch * 8) = o;
      };
#pragma unroll 1
      for (int i = 0; i < 8; ++i) {
        const int tok = (wave >> 2) * 16 + 2 * i + (lane >> 5);
        const int gi = (wave + i) & 3;
        if (gi == 0) pool_tok(std::integral_constant<int, 1>{}, tok, gi);
        else if (gi == 1) pool_tok(std::integral_constant<int, 2>{}, tok, gi);
        else if (gi == 2) pool_tok(std::integral_constant<int, 4>{}, tok, gi);
        else pool_tok(std::integral_constant<int, 8>{}, tok, gi);
      }
    }
  }
  __syncthreads();
}

#define XBAR() do { XcdBarrier xb_; xb_.bar = (unsigned*)(load_params().ws + WS_BAR); xb_.x = xb_xcc_id(); xb_.st = (volatile LAS unsigned*)(lds + 131072); xcd_barrier(xb_); } while (0)

template <int layer> __device__ __forceinline__ void mixer_out_phase(LAS unsigned char* lds) {
#pragma unroll 1
  for (int b = 0; b < NB; ++b) {
    const Params p = load_params(); unsigned char* ws = p.ws;
    pg8::Gemm g = layer == 0 ? pg8::Gemm{(const bf16_t*)(ws + WS_CAT) + (size_t)b * SEQL * DM, (const bf16_t*)(ws + WS_WOUT), DM, DM, 0}
                             : pg8::Gemm{(const bf16_t*)(ws + WS_CAT) + (size_t)b * SEQL * DM, (const bf16_t*)(ws + WS_WPOOL), DM, 256, 256};
    pg8::StaticOrder S; S.init(SEQL, DM, gridDim.x, blockIdx.x);
    EpiResNorm<layer> E{b};
    pg8::gemm_phase(lds, g, S, E);
  }
}

__global__ void __launch_bounds__(NTHREADS, 2) fwd_megakernel(Params p_arg) {
  extern __shared__ __attribute__((aligned(16))) unsigned char lds_raw[];
  LAS unsigned char* lds = (LAS unsigned char*)lds_raw;
  cg::grid_group grid = cg::this_grid();
  { volatile LAS unsigned* bst = (volatile LAS unsigned*)(lds + 131072);
    if (threadIdx.x < 4) bst[threadIdx.x] = 0u;
    if ((threadIdx.x & 63) == 0) *(volatile LAS unsigned*)(size_t)(LDS_WAVETAB + 4 * __builtin_amdgcn_s_getreg((5 << 11) | 4)) = threadIdx.x >> 6;
    __syncthreads();
    (void)xcd_barrier_post((unsigned*)(load_params().ws + WS_BAR), bst); }

  { const Params p = load_params(); phase_prep(p, lds); }
  if (p_arg.out == nullptr) grid.sync();
  XBAR();
  { const Params p = load_params(); unsigned char* ws = p.ws; const float* MOD = (const float*)(ws + WS_MOD); bf16_t* H = (bf16_t*)(ws + WS_H);
    const int tid = opaque_tid(), lane = tid & 63, wave = tid >> 6, gw = blockIdx.x * NWAVES + wave, NGW = gridDim.x * NWAVES;
    constexpr int RB = 4;
    f32x4 vc[4]; const bool hasc = NT + gw < NTALL;
    if (hasc) { const f32x4* xr = (const f32x4*)(p.ctx + (size_t)gw * DM) + lane;
#pragma unroll
      for (int j = 0; j < 4; ++j) vc[j] = xr[64 * j]; }
#pragma unroll 1
    for (int cls = 0; cls < 3; ++cls) {
      const int rbeg = cls == 0 ? 0 : (cls == 1 ? SEQL : NT), rend = cls == 0 ? SEQL : (cls == 1 ? NT : NTALL);
      const float* m = MOD + (size_t)cls * 6144;
      f32x4 A[4], B[4];
#pragma unroll
      for (int j = 0; j < 4; ++j) { A[j] = ((const f32x4*)p.norm1_g)[lane + 64 * j] * (((const f32x4*)(m + DM))[lane + 64 * j] + 1.0f); B[j] = ((const f32x4*)m)[lane + 64 * j]; }
      if (cls == 2 && hasc) { const int r = NT + gw; float ss = 0.f;
#pragma unroll
        for (int j = 0; j < 4; ++j) ss += (vc[j][0] * vc[j][0] + vc[j][1] * vc[j][1]) + (vc[j][2] * vc[j][2] + vc[j][3] * vc[j][3]);
        const float rr = rsqrtf(wave_sum(ss) * (1.0f / DM) + 1e-6f);
        u32x2* o8 = (u32x2*)(H + (size_t)r * DM) + lane;
#pragma unroll
        for (int j = 0; j < 4; ++j) { const f32x4 y = (vc[j] * rr) * A[j] + B[j]; u32x2 w; w.x = pk2(y[0], y[1]); w.y = pk2(y[2], y[3]); o8[64 * j] = w; } }
#pragma unroll 1
      for (int r0 = rbeg + gw + (cls == 2 ? NGW : 0); r0 < rend; r0 += RB * NGW) {
        f32x4 v[RB][4];
#pragma unroll
        for (int q = 0; q < RB; ++q) { const int r = min(r0 + q * NGW, rend - 1); const f32x4* xr = (const f32x4*)(r < NT ? p.x + (size_t)r * DM : p.ctx + (size_t)(r - NT) * DM) + lane;
#pragma unroll
          for (int j = 0; j < 4; ++j) v[q][j] = xr[64 * j]; }
#pragma unroll
        for (int q = 0; q < RB; ++q) { const int r = r0 + q * NGW; if (r >= rend) break;
          float ss = 0.f;
#pragma unroll
          for (int j = 0; j < 4; ++j) ss += (v[q][j][0] * v[q][j][0] + v[q][j][1] * v[q][j][1]) + (v[q][j][2] * v[q][j][2] + v[q][j][3] * v[q][j][3]);
          const float rr = rsqrtf(wave_sum(ss) * (1.0f / DM) + 1e-6f);
          u32x2* o8 = (u32x2*)(H + (size_t)r * DM) + lane;
#pragma unroll
          for (int j = 0; j < 4; ++j) { const f32x4 y = (v[q][j] * rr) * A[j] + B[j]; u32x2 w; w.x = pk2(y[0], y[1]); w.y = pk2(y[2], y[3]); o8[64 * j] = w; }
        }
      }
    } }
  XBAR();
  { const Params p = load_params(); unsigned char* ws = p.ws;
    pg8::Gemm g{(const bf16_t*)(ws + WS_H), (const bf16_t*)(ws + WS_WIN), DM, DM, 0}; pg8::OrderG1 S; S.so.init(NT, INW, gridDim.x, blockIdx.x);
    EpiG1 E{(bf16_t*)(ws + WS_QB), (bf16_t*)(ws + WS_KB), (bf16_t*)(ws + WS_VT), (bf16_t*)(ws + WS_KC), (bf16_t*)(ws + WS_VCT), (bf16_t*)(ws + WS_UB), (bf16_t*)(ws + WS_GT), (const float*)(ws + WS_ROPE)};
    pg8::gemm_phase(lds, g, S, E);
    { const int G = gridDim.x, nunits = 898, maxu = (nunits + G - 1) / G, nfull = nunits - (maxu - 1) * G;
      const int nslack = (nfull == G) ? 0 : G - nfull; const int tid2 = opaque_tid();
      const int per_round = nslack * NWAVES * 4, rmain = nslack == 0 ? 0 : (2 * NEXP / per_round) * per_round;
      if (nslack == 0) convert_tables(p, 1, blockIdx.x * NWAVES + (tid2 >> 6), G * NWAVES, tid2 & 63);
      else if ((int)blockIdx.x >= nfull) convert_tables(p, 1, ((int)blockIdx.x - nfull) * NWAVES + (tid2 >> 6), nslack * NWAVES, tid2 & 63, 0, rmain);
      else if (rmain < 2 * NEXP) convert_tables(p, 1, (int)blockIdx.x * NWAVES + (tid2 >> 6), nfull * NWAVES, tid2 & 63, rmain, 2 * NEXP); } }
  XBAR();
  { const Params p = load_params(); attn_phase(p, lds); }
  { const Params p = load_params(); gmlp_phase(p, lds); }
  XBAR();
  mixer_out_phase<0>(lds);
  XBAR();
#pragma unroll 1
  for (int layer = 0; layer < 2; ++layer) {
    {
#pragma unroll 1
      for (int q = 0; q < 4; ++q) { const Params p = load_params(); unsigned char* ws = p.ws;
        pg8::Gemm g{(const bf16_t*)(ws + WS_H) + (size_t)q * 8192 * DM, (const bf16_t*)(ws + WS_WQ) + (size_t)layer * 2048 * DM, DM, DM, 0}; pg8::StaticOrder S; S.init(8192, 2048, gridDim.x, blockIdx.x);
        EpiTopK E{layer, q * 8192};
        pg8::gemm_phase(lds, g, S, E); }
      XBAR();
    }
    { const Params p = load_params(); peer_down_phase(p, layer); }
    XBAR();
    { const Params p = load_params(); peer_reduce_phase(p, layer); }
    XBAR();
    { const Params p = load_params(); peer_up_phase(p, lds, layer); }
    XBAR();
    if (layer == 0) {
      { const Params p = load_params(); pool_fused_phase(p, lds); }
      XBAR();
      mixer_out_phase<1>(lds);
      XBAR();
    } else {
      { const Params p = load_params(); final_norm_phase(p); }
    }
  }
}

extern "C" void kernel_launch(void* const* d_in, const int* in_sizes, int n_in, void* d_out, int out_size, void* d_ws, size_t ws_size, hipStream_t stream) {
  static int grid_blocks = 0;
  if (grid_blocks == 0) {
    if (n_in != 20 || ws_size < WS_END || out_size != NT * DM) { fprintf(stderr, "kernel_launch: unexpected shapes (n_in %d, ws %zu < %zu, out %d)\n", n_in, ws_size, (size_t)WS_END, out_size); grid_blocks = -1; return; }
    int dev = 0, cus = 0, per_cu = 0;
    (void)hipGetDevice(&dev);
    (void)hipDeviceGetAttribute(&cus, hipDeviceAttributeMultiprocessorCount, dev);
    if (hipFuncSetAttribute((const void*)fwd_megakernel, hipFuncAttributeMaxDynamicSharedMemorySize, LDS_BYTES) != hipSuccess) { fprintf(stderr, "kernel_launch: hipFuncSetAttribute failed\n"); grid_blocks = -1; return; }
    if (hipOccupancyMaxActiveBlocksPerMultiprocessor(&per_cu, (const void*)fwd_megakernel, NTHREADS, LDS_BYTES) != hipSuccess || per_cu < 1) { fprintf(stderr, "kernel_launch: occupancy query says %d blocks per CU\n", per_cu); grid_blocks = -1; return; }
    if (cus != 256) { fprintf(stderr, "kernel_launch: this kernel is laid out for 256 CUs (one 256 x 256 GEMM unit per workgroup in the fused phases), found %d\n", cus); grid_blocks = -1; return; }
    grid_blocks = cus;
  }
  if (grid_blocks < 0) return;
  Params p{};
  p.x = (const float*)d_in[0]; p.c = (const float*)d_in[1]; p.ctx = (const float*)d_in[2]; p.c_ctx = (const float*)d_in[3]; p.mod_w = (const float*)d_in[4]; p.mod_b = (const float*)d_in[5];
  p.norm1_g = (const float*)d_in[6]; p.norm2_g = (const float*)d_in[7]; p.attn_in_w = (const float*)d_in[8]; p.attn_out_w = (const float*)d_in[9]; p.attn_sink = (const float*)d_in[10];
  p.gmlp_w_s = (const float*)d_in[11]; p.gmlp_b_s = (const float*)d_in[12]; p.pool_w = (const float*)d_in[13]; p.pool_scale = (const float*)d_in[14]; p.peer_w_q = (const float*)d_in[15];
  p.peer_sub_keys = (const float*)d_in[16]; p.peer_down = (const float*)d_in[17]; p.peer_up = (const float*)d_in[18]; p.final_g = (const float*)d_in[19];
  p.out = (float*)d_out; p.ws = (unsigned char*)d_ws;
  (void)hipMemsetAsync((char*)d_ws + WS_BAR, 0, WS_XCNT + XCNT_BYTES - WS_BAR, stream);
  void* args[] = {&p};
  hipError_t e = hipLaunchCooperativeKernel((void*)fwd_megakernel, dim3(grid_blocks), dim3(NTHREADS), args, LDS_BYTES, stream);
  if (e != hipSuccess) fprintf(stderr, "cooperative launch failed: %s (grid %d)\n", hipGetErrorString(e), grid_blocks);
}
```
